# Optimizing an MI355X kernel written in HIP

```python
import math
import jax, jax.numpy as jnp
from jax import lax
import numpy as np

D_MODEL = 1024
BATCH = 16
SEQ = 2048
DEPTH = 1

CHUNK = 64
Q_BLOCK = 128
ROPE_THETA = 500000.0
D_MIX = D_MODEL
MLA_HEADS = 8
MLA_NOPE_DIM = 64
MLA_ROPE_DIM = 32
MLA_V_DIM = 64
MLA_QK_DIM = MLA_NOPE_DIM + MLA_ROPE_DIM
Q_RANK = 384
KV_RANK = 256
DIFF_HEADS = 4
DIFF_HEAD_DIM = 64
DIFF_ROPE_DIM = DIFF_HEAD_DIM // 4
IN_WIDTHS = (Q_RANK, KV_RANK, MLA_ROPE_DIM,
             DIFF_HEADS * 2 * DIFF_HEAD_DIM, DIFF_HEADS * 2 * DIFF_HEAD_DIM, DIFF_HEADS * 2 * DIFF_HEAD_DIM)
IN_COLS = sum(IN_WIDTHS)
N_EXPERTS = 32
TOP_K = 4
EXPERT_DFF = D_MODEL
SWIGLU_LIMIT = 7.0
SWIGLU_ALPHA = 1.702
MOE_BLOCK = 128
N_MOD = 6

kernel_name = "hybrid_mla_diffattn_moe_adaln_block"


def rms_norm(x, g, eps=1e-6):
    xf = x.astype(jnp.float32)
    y = xf * lax.rsqrt(jnp.mean(xf * xf, axis=-1, keepdims=True) + eps)
    return (y * g.astype(jnp.float32)).astype(x.dtype)


def apply_rope(x, positions, rot_dim):
    half = rot_dim // 2
    inv_freq = ROPE_THETA ** (-jnp.arange(half, dtype=jnp.float32) / half)
    ang = positions.astype(jnp.float32)[:, :, None] * inv_freq
    ang = ang.reshape(ang.shape[:2] + (1,) * (x.ndim - 3) + (half,))
    cos, sin = jnp.cos(ang), jnp.sin(ang)
    xr = x[..., :rot_dim].astype(jnp.float32)
    x1, x2 = xr[..., :half], xr[..., half:]
    rot = jnp.concatenate([x1 * cos - x2 * sin, x2 * cos + x1 * sin], axis=-1).astype(x.dtype)
    return jnp.concatenate([rot, x[..., rot_dim:]], axis=-1)


def _split_query_blocks(q):
    *lead, s, d = q.shape
    return jnp.moveaxis(q.reshape(*lead, s // Q_BLOCK, Q_BLOCK, d), -3, 0)


def _merge_query_blocks(o):
    o = jnp.moveaxis(o, 0, -3)
    *lead, nb, qb, d = o.shape
    return o.reshape(*lead, nb * qb, d)


def _chunk_causal_mask(blk, s):
    q_idx = blk * Q_BLOCK + jnp.arange(Q_BLOCK)
    k_idx = jnp.arange(s)
    return (k_idx[None, :] // CHUNK) <= (q_idx[:, None] // CHUNK)


def mla_attention(q, k, v):
    s = q.shape[-2]
    scale = MLA_QK_DIM ** -0.5

    def one_block(args):
        qb, blk = args
        sc = jnp.einsum('bhqd,bhkd->bhqk', qb, k).astype(jnp.float32) * scale
        sc = jnp.where(_chunk_causal_mask(blk, s), sc, -jnp.inf)
        p = jax.nn.softmax(sc, axis=-1).astype(v.dtype)
        return jnp.einsum('bhqk,bhkd->bhqd', p, v)

    out = lax.map(one_block, (_split_query_blocks(q), jnp.arange(s // Q_BLOCK)))
    return _merge_query_blocks(out)


def diff_attention(q, k, v, lam):
    s = q.shape[-2]
    scale = DIFF_HEAD_DIM ** -0.5

    def one_block(args):
        qb, blk = args
        sc = jnp.einsum('bhcqd,bhckd->bhcqk', qb, k).astype(jnp.float32) * scale
        sc = jnp.where(_chunk_causal_mask(blk, s), sc, -jnp.inf)
        p = jax.nn.softmax(sc, axis=-1)
        w = (p[:, :, 0] - lam * p[:, :, 1]).astype(v.dtype)
        return jnp.einsum('bhqk,bhkd->bhqd', w, v)

    out = lax.map(one_block, (_split_query_blocks(q), jnp.arange(s // Q_BLOCK)))
    return _merge_query_blocks(out)


def hybrid_mixer(h, positions, w_in, g_q_norm, w_uq, g_kv_norm, w_ukv,
                 lambda_q1, lambda_k1, lambda_q2, lambda_k2, g_subln, w_out, lambda_init):
    b, s, _ = h.shape
    proj = h @ w_in
    cuts = list(np.cumsum(IN_WIDTHS)[:-1])
    c_q, c_kv, k_pe, dq, dk, dv = jnp.split(proj, cuts, axis=-1)

    q = (rms_norm(c_q, g_q_norm) @ w_uq).reshape(b, s, MLA_HEADS, MLA_QK_DIM)
    q = jnp.concatenate([q[..., :MLA_NOPE_DIM],
                         apply_rope(q[..., MLA_NOPE_DIM:], positions, MLA_ROPE_DIM)], axis=-1)
    kv = (rms_norm(c_kv, g_kv_norm) @ w_ukv).reshape(b, s, MLA_HEADS, MLA_NOPE_DIM + MLA_V_DIM)
    k_nope, v_m = kv[..., :MLA_NOPE_DIM], kv[..., MLA_NOPE_DIM:]
    k_pe = apply_rope(k_pe[:, :, None, :], positions, MLA_ROPE_DIM)
    k = jnp.concatenate([k_nope, jnp.broadcast_to(k_pe, (b, s, MLA_HEADS, MLA_ROPE_DIM))], axis=-1)
    o_mla = mla_attention(q.transpose(0, 2, 1, 3), k.transpose(0, 2, 1, 3), v_m.transpose(0, 2, 1, 3))
    o_mla = o_mla.transpose(0, 2, 1, 3).reshape(b, s, MLA_HEADS * MLA_V_DIM)

    dq = apply_rope(dq.reshape(b, s, DIFF_HEADS, 2, DIFF_HEAD_DIM), positions, DIFF_ROPE_DIM)
    dk = apply_rope(dk.reshape(b, s, DIFF_HEADS, 2, DIFF_HEAD_DIM), positions, DIFF_ROPE_DIM)
    dv = dv.reshape(b, s, DIFF_HEADS, 2 * DIFF_HEAD_DIM).transpose(0, 2, 1, 3)
    lam = (jnp.exp(jnp.sum(lambda_q1.astype(jnp.float32) * lambda_k1.astype(jnp.float32)))
           - jnp.exp(jnp.sum(lambda_q2.astype(jnp.float32) * lambda_k2.astype(jnp.float32)))
           + lambda_init)
    o_diff = diff_attention(dq.transpose(0, 2, 3, 1, 4), dk.transpose(0, 2, 3, 1, 4), dv, lam)
    o_diff = rms_norm(o_diff, g_subln, eps=1e-5) * (1.0 - lambda_init)
    o_diff = o_diff.transpose(0, 2, 1, 3).reshape(b, s, DIFF_HEADS * 2 * DIFF_HEAD_DIM)

    return jnp.concatenate([o_mla, o_diff], axis=-1) @ w_out


def clamped_swiglu(gu):
    gate, up = gu[..., ::2], gu[..., 1::2]
    gate = jnp.minimum(gate, SWIGLU_LIMIT)
    up = jnp.clip(up, -SWIGLU_LIMIT, SWIGLU_LIMIT)
    return gate * jax.nn.sigmoid(SWIGLU_ALPHA * gate) * (up + 1.0)


def moe_ffn(t, w_router, b_router, w_gate_up, b_gate_up, w_down, b_down):
    n, d = t.shape
    logits = (t @ w_router + b_router).astype(jnp.float32)
    top_val, top_idx = lax.top_k(logits, TOP_K)
    top_w = jax.nn.softmax(top_val, axis=-1)
    a = n * TOP_K
    flat_e = top_idx.reshape(a)
    flat_tok = jnp.arange(a, dtype=jnp.int32) // TOP_K
    flat_w = top_w.reshape(a)
    order = jnp.argsort(flat_e)
    sorted_e = flat_e[order]
    counts = jnp.bincount(flat_e, length=N_EXPERTS)
    padded = (counts + MOE_BLOCK - 1) // MOE_BLOCK * MOE_BLOCK
    start_sorted = jnp.cumsum(counts) - counts
    end_padded = jnp.cumsum(padded)
    start_padded = end_padded - padded
    slot = start_padded[sorted_e] + jnp.arange(a) - start_sorted[sorted_e]
    p = a + N_EXPERTS * MOE_BLOCK
    slot_tok = jnp.zeros((p,), jnp.int32).at[slot].set(flat_tok[order])
    slot_w = jnp.zeros((p,), jnp.float32).at[slot].set(flat_w[order])
    nblk = p // MOE_BLOCK
    blk_expert = jnp.minimum(
        jnp.searchsorted(end_padded, jnp.arange(nblk) * MOE_BLOCK, side='right'), N_EXPERTS - 1)

    def one_block(args):
        tok, wgt, e = args
        xb = t[tok]
        act = clamped_swiglu(xb @ w_gate_up[e] + b_gate_up[e])
        y = act @ w_down[e] + b_down[e]
        return y * wgt[:, None].astype(y.dtype)

    y = lax.map(one_block, (slot_tok.reshape(nblk, MOE_BLOCK),
                            slot_w.reshape(nblk, MOE_BLOCK), blk_expert))
    return jnp.zeros_like(t).at[slot_tok].add(y.reshape(p, d))


def setup_inputs(seed: int = 0) -> dict:
    key = jax.random.key(seed)
    ks = jax.random.split(key, 32)
    f32 = jnp.float32
    nrm = lambda k, shape, scale: jax.random.normal(k, shape, f32) * scale
    gain = lambda k, shape: 1.0 + 0.02 * jax.random.normal(k, shape, f32)
    L = DEPTH
    offset = jax.random.randint(ks[2], (BATCH, 1), 0, 4096, dtype=jnp.int32)
    positions = offset + jnp.arange(SEQ, dtype=jnp.int32)[None, :]
    return {
        "x": nrm(ks[0], (BATCH, SEQ, D_MODEL), 1.0),
        "c": nrm(ks[1], (BATCH, D_MODEL), 1.0),
        "positions": positions,
        "w_ada": nrm(ks[3], (L, D_MODEL, N_MOD * D_MODEL), 0.5 * D_MODEL ** -0.5),
        "b_ada": nrm(ks[4], (L, N_MOD * D_MODEL), 0.01),
        "g_norm1": gain(ks[5], (L, D_MODEL)),
        "w_in": nrm(ks[6], (L, D_MODEL, IN_COLS), D_MODEL ** -0.5),
        "g_q_norm": gain(ks[7], (L, Q_RANK)),
        "w_uq": nrm(ks[8], (L, Q_RANK, MLA_HEADS * MLA_QK_DIM), Q_RANK ** -0.5),
        "g_kv_norm": gain(ks[9], (L, KV_RANK)),
        "w_ukv": nrm(ks[10], (L, KV_RANK, MLA_HEADS * (MLA_NOPE_DIM + MLA_V_DIM)), KV_RANK ** -0.5),
        "lambda_q1": nrm(ks[11], (L, DIFF_HEAD_DIM), 0.1),
        "lambda_k1": nrm(ks[12], (L, DIFF_HEAD_DIM), 0.1),
        "lambda_q2": nrm(ks[13], (L, DIFF_HEAD_DIM), 0.1),
        "lambda_k2": nrm(ks[14], (L, DIFF_HEAD_DIM), 0.1),
        "g_subln": gain(ks[15], (L, 2 * DIFF_HEAD_DIM)),
        "w_out": nrm(ks[16], (L, D_MIX, D_MODEL), D_MIX ** -0.5),
        "g_norm2": gain(ks[17], (L, D_MODEL)),
        "w_router": nrm(ks[18], (L, D_MODEL, N_EXPERTS), D_MODEL ** -0.5),
        "b_router": nrm(ks[19], (L, N_EXPERTS), 0.01),
        "w_gate_up": nrm(ks[20], (L, N_EXPERTS, D_MODEL, 2 * EXPERT_DFF), D_MODEL ** -0.5),
        "b_gate_up": nrm(ks[21], (L, N_EXPERTS, 2 * EXPERT_DFF), 0.01),
        "w_down": nrm(ks[22], (L, N_EXPERTS, EXPERT_DFF, D_MODEL), EXPERT_DFF ** -0.5),
        "b_down": nrm(ks[23], (L, N_EXPERTS, D_MODEL), 0.01),
        "g_final": gain(ks[24], (D_MODEL,)),
    }


def reference(x, c, positions, w_ada, b_ada, g_norm1, w_in, g_q_norm, w_uq, g_kv_norm, w_ukv,
              lambda_q1, lambda_k1, lambda_q2, lambda_k2, g_subln, w_out, g_norm2,
              w_router, b_router, w_gate_up, b_gate_up, w_down, b_down, g_final):
    b, s, d = x.shape
    for l in range(DEPTH):
        lambda_init = 0.8 - 0.6 * math.exp(-0.3 * l)
        mod = jax.nn.silu(c) @ w_ada[l] + b_ada[l]
        sh1, sc1, gt1, sh2, sc2, gt2 = jnp.split(mod[:, None, :], N_MOD, axis=-1)
        h = rms_norm(x, g_norm1[l]) * (1.0 + sc1) + sh1
        mix = hybrid_mixer(h, positions, w_in[l], g_q_norm[l], w_uq[l], g_kv_norm[l], w_ukv[l],
                           lambda_q1[l], lambda_k1[l], lambda_q2[l], lambda_k2[l], g_subln[l],
                           w_out[l], lambda_init)
        x = x + gt1 * mix
        h = rms_norm(x, g_norm2[l]) * (1.0 + sc2) + sh2
        y = moe_ffn(h.reshape(b * s, d), w_router[l], b_router[l], w_gate_up[l], b_gate_up[l],
                    w_down[l], b_down[l]).reshape(b, s, d)
        x = x + gt2 * y
    return rms_norm(x, g_final)
```

```cpp
#include <hip/hip_runtime.h>
#include <cstdio>
#include <cstdint>
constexpr int NB = 16, SEQ = 2048, DM = 1024, MTOK = NB * SEQ;
constexpr int QRANK = 384, KVRANK = 256, ROPE_D = 32, NOPE_D = 64, MLA_V = 64, MLA_QK = 96, MLA_H = 8;
constexpr int DIFF_H = 4, DIFF_D = 64;
constexpr int INCOLS = 2208;
constexpr int C_CQ = 0, C_CKV = 384, C_KPE = 640, C_DQ = 672, C_DK = 1184, C_DV = 1696;
constexpr int NEXP = 32, TOPK = 4, DFF = 1024;
constexpr int NMOD = 6 * DM;
constexpr float LAMBDA_INIT = 0.2f;

__constant__ float INVF16[16] = {1.000000000e+00f, 4.403665960e-01f, 1.939227432e-01f, 8.539710194e-02f, 3.760603070e-02f, 1.656044088e-02f, 7.292664610e-03f, 3.211446106e-03f,
                                 1.414213562e-03f, 6.227724371e-04f, 2.742481884e-04f, 1.207697351e-04f, 5.318295734e-05f, 2.341999971e-05f, 1.031338525e-05f, 4.541670478e-06f};
__constant__ float INVF8[8] = {1.000000000e+00f, 1.939227432e-01f, 3.760603070e-02f, 7.292664610e-03f, 1.414213562e-03f, 2.742481884e-04f, 5.318295734e-05f, 1.031338525e-05f};

constexpr size_t MiB = 1u << 20;

__device__ __forceinline__ float wave_sum(float v) {
#pragma unroll
    for (int o = 1; o < 64; o <<= 1) v += __shfl_xor(v, o);
    return v;
}

#ifndef PROBE_REP
#define PROBE_REP 0
#endif
#define LAS __attribute__((address_space(3)))
#define GAS __attribute__((address_space(1)))
typedef unsigned short bf16_t;
typedef short bf16x8 __attribute__((ext_vector_type(8)));
typedef float f32x4 __attribute__((ext_vector_type(4)));
typedef float f32x16 __attribute__((ext_vector_type(16)));
typedef unsigned u32x4 __attribute__((ext_vector_type(4)));
typedef unsigned u32x2 __attribute__((ext_vector_type(2)));

constexpr size_t F_CTL = 0;
constexpr size_t F_MOD = 512 * 1024;
constexpr size_t F_MISC = 1 * MiB;
constexpr size_t F_ROPE = 2 * MiB;
constexpr size_t F_SSQP = 8 * MiB;
constexpr size_t F_TOPI = 11 * MiB;
constexpr size_t F_TOPW = 11 * MiB + 512 * 1024;
constexpr size_t F_TPOS = 12 * MiB;
constexpr size_t F_LIST = 890 * MiB;
constexpr size_t F_LW = 894 * MiB;
constexpr size_t F_WIN = 16 * MiB;
constexpr size_t F_WUQ = 21 * MiB;
constexpr size_t F_WUKV = 22 * MiB;
constexpr size_t F_WOUT = 23 * MiB;
constexpr size_t F_WGU = 26 * MiB;
constexpr size_t F_WD = 154 * MiB;
constexpr size_t F_X1 = 218 * MiB;
constexpr size_t F_R1 = 346 * MiB;
constexpr size_t F_H1 = F_R1, F_ATT = F_R1 + 64 * MiB, F_HS = F_R1, F_Y = F_R1;
constexpr size_t F_R2 = 618 * MiB;
constexpr size_t F_PROJ = F_R2, F_QMLA = F_R2 + 144 * MiB, F_KV = F_QMLA + 48 * MiB, F_H2 = F_R1, F_ACT = F_R2;
constexpr size_t F_O1S = 898 * MiB;
constexpr size_t F_MODP = 914 * MiB;
constexpr size_t F_END = 921 * MiB;
constexpr int PROJ_LD = 2304;
constexpr int P_CQ = 0, P_CKV = 384, P_DQ = 640, P_DK = 1152, P_DV = 1664, P_KPE = 2176;
constexpr int SROWS_MAX = 139264;
constexpr float C2_MLA = 0.10206207261596575f * 1.4426950408889634f, C2_DIFF = 0.125f * 1.4426950408889634f;
constexpr int CW_BAR = 4096;
constexpr int CW_CNT = 2048;
constexpr int CW_MODC = 1024;

__device__ __forceinline__ unsigned f2bf(float f) { unsigned u = __builtin_bit_cast(unsigned, f); return (u + 0x7fffu + ((u >> 16) & 1u)) >> 16; }
__device__ __forceinline__ unsigned pk2(float lo, float hi) { return f2bf(lo) | (f2bf(hi) << 16); }
__device__ __forceinline__ float bf2f(unsigned short h) { return __builtin_bit_cast(float, (unsigned)h << 16); }
__device__ __forceinline__ unsigned cvt_pk_bf16(float lo, float hi) { unsigned r; asm volatile("v_cvt_pk_bf16_f32 %0, %1, %2" : "=v"(r) : "v"(lo), "v"(hi)); return r; }

#define XB_TMO      128
#define XB_XCNT(j)  (256  + 64 * (j))
#define XB_XSUB(j)  (1280 + 64 * (j))
#define XB_XGEN(j)  (2304 + 64 * (j))
#define XB_TOP      3328
#define XB_TOPGEN   3392
#define XCD_BAR_WORDS 3456
#define XB_SPIN_CAP (1u << 20)
__device__ __forceinline__ unsigned xb_ld(unsigned* p)              { return __hip_atomic_load(p, __ATOMIC_RELAXED, __HIP_MEMORY_SCOPE_AGENT); }
__device__ __forceinline__ unsigned xb_add(unsigned* p, unsigned v) { return __hip_atomic_fetch_add(p, v, __ATOMIC_RELAXED, __HIP_MEMORY_SCOPE_AGENT); }
__device__ __forceinline__ unsigned xb_xcc_id() { return (unsigned)__builtin_amdgcn_s_getreg((3 << 11) | 20) & 0xFu; }
#define XB_SPIN(cond, bar) do { unsigned _sp = 0; while (cond) { __builtin_amdgcn_s_sleep(1); \
    if ((++_sp & 255u) == 0u) { if (xb_ld(&(bar)[XB_TMO])) break; if (_sp > XB_SPIN_CAP) { atomicAdd(&(bar)[XB_TMO], 1u); break; } } } } while (0)
struct XcdBarrier { unsigned* bar; unsigned x; volatile LAS unsigned* st; };
__device__ __forceinline__ XcdBarrier xcd_barrier_post(unsigned* bar, volatile LAS unsigned* st) {
    XcdBarrier b; b.bar = bar; b.x = xb_xcc_id(); b.st = st;
    if (threadIdx.x == 0) (void)xb_add(&bar[XB_XCNT(b.x)], 1u);
    return b;
}
__device__ __forceinline__ void xcd_barrier_complete(unsigned* bar, unsigned x, unsigned& nloc, unsigned& nx) {
    const unsigned G = gridDim.x * gridDim.y * gridDim.z;
    unsigned sum, cnt, mine, sp = 0u;
    for (;;) {
        sum = 0u; cnt = 0u; mine = 0u;
#pragma unroll
        for (unsigned j = 0; j < 16; ++j) { const unsigned c = xb_ld(&bar[XB_XCNT(j)]); sum += c; cnt += (c > 0u) ? 1u : 0u; mine = (j == x) ? c : mine; }
        if (sum == G) break;
        __builtin_amdgcn_s_sleep(1);
        if ((++sp & 255u) == 0u) { if (xb_ld(&bar[XB_TMO])) break; if (sp > XB_SPIN_CAP) { atomicAdd(&bar[XB_TMO], 1u); break; } }
    }
    nloc = mine > 0u ? mine : 1u; nx = cnt > 0u ? cnt : 1u;
}
__device__ __forceinline__ void xcd_barrier(const XcdBarrier& b) {
    asm volatile("s_waitcnt vmcnt(0)" ::: "memory");
    __syncthreads();
    if (threadIdx.x == 0) {
        unsigned* bar = b.bar;
        __builtin_amdgcn_s_waitcnt(0);
        unsigned nloc = b.st[0], nx = b.st[1];
        if (nloc == 0u) { xcd_barrier_complete(bar, b.x, nloc, nx); b.st[0] = nloc; b.st[1] = nx; }
        const unsigned old = xb_add(&bar[XB_XSUB(b.x)], 1u);
        const unsigned gen = old / nloc;
        if (old + 1u == (gen + 1u) * nloc) {
            __builtin_amdgcn_fence(__ATOMIC_RELEASE, "agent");
            asm volatile("s_waitcnt vmcnt(0)" ::: "memory");
            const unsigned og = xb_add(&bar[XB_TOP], 1u);
            const unsigned tg = og / nx;
            if (og + 1u == (tg + 1u) * nx) xb_add(&bar[XB_TOPGEN], 1u);
            else XB_SPIN(xb_ld(&bar[XB_TOPGEN]) == tg, bar);
            __builtin_amdgcn_fence(__ATOMIC_ACQUIRE, "agent");
            xb_add(&bar[XB_XGEN(b.x)], 1u);
            asm volatile("s_waitcnt vmcnt(0)" ::: "memory");
        } else {
            XB_SPIN(xb_ld(&bar[XB_XGEN(b.x)]) == gen, bar);
            __builtin_amdgcn_fence(__ATOMIC_ACQUIRE, "agent");
            asm volatile("s_waitcnt vmcnt(0)" ::: "memory");
        }
    }
    __syncthreads();
}

namespace pg8 {
constexpr int BM = 256, BK = 64, HALF = 128, HTB = HALF * BK * 2, STAGE_BYTES = 8 * HTB, NXCD = 8, WGM = 8;
__host__ __device__ __forceinline__ int lds_byte(int r, int c) { const int st = (r >> 4) * 2 + (c >> 5), rr = r & 15, cc = c & 31, ob = rr * 64 + cc * 2; return st * 1024 + (ob ^ (((ob >> 9) & 1) << 5)); }
__host__ __device__ __forceinline__ void stage_rc(int b, int& R, int& C) { const int st = b / 1024, sb = b % 1024, swz = sb ^ (((sb >> 9) & 1) << 5); R = (st >> 1) * 16 + swz / 64; C = (st & 1) * 32 + (swz % 64) / 2; }
__host__ __device__ __forceinline__ int perm32(int rho) { const int n = rho >> 4, i = rho & 15; return 8 * (i >> 2) + 4 * n + (i & 3); }
struct Unit { int pm, pn, pb, e, jl; };
struct Gemm { const bf16_t* A; const bf16_t* Bt; int lda, K; };
struct StaticOrder {
    int nM, nN, nwg, G, c, rep;
    __device__ void init(int M, int N, int G_, int c_, int rep_ = 1) { nM = M / BM; nN = N / BM; nwg = nM * nN; G = G_; c = c_; rep = rep_; }
    __device__ bool next(int i, Unit& u) const {
        long L = (long)i * G + c; if (L >= (long)nwg * rep) return false;
        L %= nwg;
        int wgid = (int)L; { const int q = nwg / NXCD, r = nwg % NXCD, xcd = wgid % NXCD, off = wgid / NXCD; wgid = (xcd < r ? xcd * (q + 1) : r * (q + 1) + (xcd - r) * q) + off; }
        const int nig = WGM * nN, gid = wgid / nig, fm = gid * WGM, gsz = (nM - fm) < WGM ? (nM - fm) : WGM;
        u.pm = fm + ((wgid % nig) % gsz); u.pn = (wgid % nig) / gsz; u.pb = u.pn; u.e = 0; u.jl = 0; return true;
    }
};
struct GroupOrder {
    StaticOrder so; const LAS int* texp;
    __device__ bool next(int i, Unit& u) const { if (!so.next(i, u)) return false; u.e = texp[u.pm]; u.jl = u.pm - texp[544 + u.e]; u.pb = u.e * so.nN + u.pn; return true; }
};

struct GatherInfo { const int* list; const LAS int* cnt; LAS int* idx; };
template <class Epi, class Sched, bool ALIGN_EPI = false, bool SP2 = false, bool GATHER = false>
__device__ __forceinline__ void gemm_phase(LAS unsigned char* lds, const Gemm g, const Sched& S, const Epi& E, const GatherInfo gi = GatherInfo{nullptr, nullptr, nullptr}) {
    static_assert(SP2, "only the two-super-phase loop is kept");
    const int tid = threadIdx.x, wid = __builtin_amdgcn_readfirstlane(tid >> 6), lane = tid & 63, wr = wid >> 2, wc = wid & 3, fr = lane & 15, fq = lane >> 4;
    const int K = g.K, nt = K / BK, lda = g.lda;
    unsigned voffA2[2][2], voffB[2]; int gR[2], gC[2];
#pragma unroll
    for (int i = 0; i < 2; ++i) { int R, C; stage_rc(tid * 16 + i * 8192, R, C); const int Rb = Epi::PERM ? ((R & ~31) + perm32(R & 31)) : R;
        voffA2[0][i] = voffA2[1][i] = (unsigned)(R * lda + C) * 2u; voffB[i] = (unsigned)(Rb * K + C) * 2u; gR[i] = R; gC[i] = C; }
    const size_t kstep = (size_t)(BK * 2);
    const size_t hstepA = GATHER ? 0 : (size_t)HALF * lda * 2, hstepB = (size_t)HALF * K * 2;
    const size_t tstepA = 2 * hstepA, tstepB = 2 * hstepB;
    const unsigned ldsw = (unsigned)wid * 1024u;
    const int aoff = lds_byte(wr * 64 + fr, fq * 8), boff = lds_byte(wc * 32 + fr, fq * 8);
#define PG8_SA(b, h) (((b) * 2 + (h)) * HTB)
#define PG8_SB(b, h) ((4 + (b) * 2 + (h)) * HTB)
#define PG8_STAGE(bufoff, gbase, voff) do { _Pragma("unroll") for (int _i = 0; _i < 2; ++_i) \
        __builtin_amdgcn_global_load_lds((const unsigned*)((const char*)(gbase) + (voff)[_i]), (LAS unsigned*)(lds + (bufoff) + ldsw + _i * 8192), 16, 0, 0); } while (0)
#define PG8_LDA(dst, b, h) do { _Pragma("unroll") for (int m = 0; m < 4; ++m) _Pragma("unroll") for (int k = 0; k < 2; ++k) dst[m][k] = *(const LAS bf16x8*)(lds + PG8_SA(b, h) + aoff + m * 2048 + k * 1024); } while (0)
#define PG8_LDB(dst, b, h) do { _Pragma("unroll") for (int n = 0; n < 2; ++n) _Pragma("unroll") for (int k = 0; k < 2; ++k) dst[n][k] = *(const LAS bf16x8*)(lds + PG8_SB(b, h) + boff + n * 2048 + k * 1024); } while (0)
#define PG8_MMA(ai, bj, At, Bt) do { __builtin_amdgcn_s_setprio(1); _Pragma("unroll") for (int m = 0; m < 4; ++m) _Pragma("unroll") for (int n = 0; n < 2; ++n) _Pragma("unroll") for (int k = 0; k < 2; ++k) \
        acc[ai][bj][m][n] = __builtin_amdgcn_mfma_f32_16x16x32_bf16(Bt[n][k], At[m][k], acc[ai][bj][m][n], 0, 0, 0); __builtin_amdgcn_s_setprio(0); } while (0)
#define PG8_WAIT_V(n) asm volatile("s_waitcnt vmcnt(" #n ")" ::: "memory")
#define PG8_WAIT_L(n) asm volatile("s_waitcnt lgkmcnt(" #n ")" ::: "memory")
#define PG8_BAR __builtin_amdgcn_s_barrier()
#define PG8_SCHED __builtin_amdgcn_sched_barrier(0)
#define PG8_GFETCH(U) do { if (wid == 0) __builtin_amdgcn_global_load_lds((const unsigned*)(gi.list + (size_t)(U).e * MTOK + (U).jl * 256 + lane * 4), (LAS unsigned*)gi.idx, 16, 0, 0); } while (0)
#define PG8_GOFFS(U) do { const int _cn = gi.cnt[(U).e] - (U).jl * 256; _Pragma("unroll") for (int _h = 0; _h < 2; ++_h) _Pragma("unroll") for (int _i = 0; _i < 2; ++_i) { \
        const int _r = _h * HALF + gR[_i]; int _t = gi.idx[_r]; _t = (_r < _cn) ? _t : 0; voffA2[_h][_i] = ((unsigned)_t * (unsigned)lda + (unsigned)gC[_i]) * 2u; } } while (0)
    Unit cur, nxt; int ui = 0;
    if (!S.next(0, cur)) return;
    f32x4 acc[2][2][4][2];
#pragma unroll
    for (int a = 0; a < 2; ++a)
#pragma unroll
        for (int b = 0; b < 2; ++b)
#pragma unroll
            for (int m = 0; m < 4; ++m)
#pragma unroll
                for (int n = 0; n < 2; ++n) acc[a][b][m][n] = (f32x4){0.f, 0.f, 0.f, 0.f};
    bf16x8 At[4][2], B0[2][2], B1[2][2];
    if constexpr (GATHER) { PG8_GFETCH(cur); PG8_WAIT_V(0); PG8_BAR; PG8_GOFFS(cur); PG8_WAIT_L(0); PG8_BAR; }
    const char* cA = (const char*)g.A + (size_t)cur.pm * tstepA; const char* cB = (const char*)g.Bt + (size_t)cur.pb * tstepB;
    {
        PG8_STAGE(PG8_SB(0, 0), cB, voffB); PG8_STAGE(PG8_SB(0, 1), cB + hstepB, voffB); PG8_STAGE(PG8_SA(0, 0), cA, voffA2[0]); PG8_STAGE(PG8_SA(0, 1), cA + hstepA, voffA2[1]);
        if (wr == 1) PG8_BAR;
        PG8_WAIT_V(2); PG8_BAR;
        PG8_STAGE(PG8_SB(1, 0), cB + kstep, voffB); PG8_STAGE(PG8_SA(1, 0), cA + kstep, voffA2[0]); PG8_STAGE(PG8_SB(1, 1), cB + hstepB + kstep, voffB);
        PG8_WAIT_V(6); PG8_BAR;
    }
    for (;;) {
        const bool has_next = S.next(ui + 1, nxt);
        if constexpr (GATHER) { if (has_next) PG8_GFETCH(nxt); }
        const char* nA = has_next ? (const char*)g.A + (size_t)nxt.pm * tstepA : cA; const char* nB = has_next ? (const char*)g.Bt + (size_t)nxt.pb * tstepB : cB;
#pragma unroll 1
        for (int t = 0; t < nt; t += 2) {
            const bool last = (t == nt - 2);
            const char* a1 = cA + (size_t)(t + 1) * kstep;
            const char* a2 = last ? nA : cA + (size_t)(t + 2) * kstep; const char* b2 = last ? nB : cB + (size_t)(t + 2) * kstep;
            const char* a3 = a2 + kstep; const char* b3 = b2 + kstep;
            PG8_LDB(B0, 0, 0); PG8_LDB(B1, 0, 1); PG8_SCHED; PG8_LDA(At, 0, 0); PG8_STAGE(PG8_SA(1, 1), a1 + hstepA, voffA2[1]);
            if constexpr (GATHER) { if (last && has_next) PG8_GOFFS(nxt); }
            PG8_WAIT_V(8); PG8_WAIT_L(0); PG8_BAR; PG8_MMA(0, 0, At, B0); PG8_MMA(0, 1, At, B1); PG8_BAR; PG8_SCHED;
            PG8_LDA(At, 0, 1); PG8_STAGE(PG8_SB(0, 0), b2, voffB); PG8_STAGE(PG8_SB(0, 1), b2 + hstepB, voffB); PG8_STAGE(PG8_SA(0, 0), a2, voffA2[0]);
            PG8_WAIT_V(8); PG8_WAIT_L(0); PG8_BAR; PG8_MMA(1, 0, At, B0); PG8_MMA(1, 1, At, B1); PG8_BAR; PG8_SCHED;
            PG8_LDB(B0, 1, 0); PG8_LDB(B1, 1, 1); PG8_SCHED; PG8_LDA(At, 1, 0); PG8_STAGE(PG8_SA(0, 1), a2 + hstepA, voffA2[1]);
            PG8_WAIT_V(8); PG8_WAIT_L(0); PG8_BAR; PG8_MMA(0, 0, At, B0); PG8_MMA(0, 1, At, B1); PG8_BAR; PG8_SCHED;
            PG8_LDA(At, 1, 1); PG8_STAGE(PG8_SB(1, 0), b3, voffB); PG8_STAGE(PG8_SB(1, 1), b3 + hstepB, voffB); PG8_STAGE(PG8_SA(1, 0), a3, voffA2[0]);
            PG8_WAIT_V(8); PG8_WAIT_L(0); PG8_BAR; PG8_MMA(1, 0, At, B0); PG8_MMA(1, 1, At, B1); PG8_BAR; PG8_SCHED;
        }
        if constexpr (ALIGN_EPI) { if (wr == 0) PG8_BAR; }
        E(acc, cur, wr, wc, fr, fq);
        if (!has_next) break;
#pragma unroll
        for (int a = 0; a < 2; ++a)
#pragma unroll
            for (int b = 0; b < 2; ++b)
#pragma unroll
                for (int m = 0; m < 4; ++m)
#pragma unroll
                    for (int n = 0; n < 2; ++n) acc[a][b][m][n] = (f32x4){0.f, 0.f, 0.f, 0.f};
        cur = nxt; cA = nA; cB = nB; ++ui;
        if constexpr (ALIGN_EPI) { if (wr == 1) PG8_BAR; }
    }
    PG8_WAIT_V(0);
    if constexpr (!ALIGN_EPI) { if (wr == 0) PG8_BAR; }
    PG8_BAR;
#undef PG8_SA
#undef PG8_SB
#undef PG8_STAGE
#undef PG8_LDA
#undef PG8_LDB
#undef PG8_MMA
#undef PG8_WAIT_V
#undef PG8_WAIT_L
#undef PG8_BAR
#undef PG8_SCHED
#undef PG8_GFETCH
#undef PG8_GOFFS
}
typedef f32x4 AccT[2][2][4][2];

struct EpiProj {
    static constexpr bool PERM = true;
    bf16_t* O; const float* rope; float* ssqp;
    __device__ __forceinline__ void operator()(const AccT& acc, const Unit& u, int wr, int wc, int fr, int fq) const {
#pragma unroll
        for (int bj = 0; bj < 2; ++bj) {
            const int G = u.pn * 8 + bj * 4 + wc;
            if (G > 68) continue;
            const bool is_sq = G < 20;
            const bool is_dq = (G >= 20 && G < 36), is_dk = (G >= 36 && G < 52), is_pe = (G == 68);
            const bool rope8 = (is_dq || is_dk) && (((G - 20) & 1) == 0);
#pragma unroll
            for (int ai = 0; ai < 2; ++ai)
#pragma unroll
                for (int m = 0; m < 4; ++m) {
                    const int row = u.pm * BM + ai * HALF + wr * 64 + m * 16 + fr;
                    float v[8];
#pragma unroll
                    for (int j = 0; j < 4; ++j) { v[j] = acc[ai][bj][m][0][j]; v[4 + j] = acc[ai][bj][m][1][j]; }
                    if (is_sq) {
                        float s = 0.f;
#pragma unroll
                        for (int j = 0; j < 8; ++j) s += v[j] * v[j];
                        s += __shfl_xor(s, 16); s += __shfl_xor(s, 32);
                        if (fq == 0) ssqp[(size_t)row * 20 + G] = s;
                    } else if (rope8) {
                        const float* T = rope + ((size_t)row * 24 + 16) * 2;
                        const float sgn = (fq == 0) ? -1.f : 1.f;
#pragma unroll
                        for (int j4 = 0; j4 < 4; ++j4) { const f32x4 cs = *(const f32x4*)(T + 4 * j4);
#pragma unroll
                            for (int jj = 0; jj < 2; ++jj) { const int j = 2 * j4 + jj; const float pr = __shfl_xor(v[j], 16); const float c = cs[2 * jj], s = cs[2 * jj + 1];
                                const float o = v[j] * c + sgn * pr * s; v[j] = (fq < 2) ? o : v[j]; } }
                    } else if (is_pe) {
                        const float* T = rope + ((size_t)row * 24 + 8 * (fq & 1)) * 2;
                        const float sgn = (fq < 2) ? -1.f : 1.f;
#pragma unroll
                        for (int j4 = 0; j4 < 4; ++j4) { const f32x4 cs = *(const f32x4*)(T + 4 * j4);
#pragma unroll
                            for (int jj = 0; jj < 2; ++jj) { const int j = 2 * j4 + jj; const float pr = __shfl_xor(v[j], 32); const float c = cs[2 * jj], s = cs[2 * jj + 1];
                                v[j] = v[j] * c + sgn * pr * s; } }
                    }
                    const float sc = is_dq ? C2_DIFF : 1.f;
                    u32x4 w; w.x = cvt_pk_bf16(v[0] * sc, v[1] * sc); w.y = cvt_pk_bf16(v[2] * sc, v[3] * sc); w.z = cvt_pk_bf16(v[4] * sc, v[5] * sc); w.w = cvt_pk_bf16(v[6] * sc, v[7] * sc);
                    *(u32x4*)(O + (size_t)row * PROJ_LD + G * 32 + 8 * fq) = w;
                }
        }
    }
};
template <bool ISQ> struct EpiUp {
    static constexpr bool PERM = true;
    bf16_t* O; const float* rope; const float* ssqp;
    __device__ __forceinline__ void operator()(const AccT& acc, const Unit& u, int wr, int wc, int fr, int fq) const {
        constexpr int LDO = ISQ ? 768 : 1024;
        const int rl = wr * 64 + fr;
        unsigned o_ss = (unsigned)rl * 20u * 4u, o_rp = ((unsigned)rl * 48u + 16u * (unsigned)(fq & 1)) * 4u, o_out = ((unsigned)rl * LDO + 8u * (unsigned)fq) * 2u;
        asm volatile("" : "+v"(o_ss), "+v"(o_rp), "+v"(o_out));
#pragma unroll
        for (int ai = 0; ai < 2; ++ai)
#pragma unroll
            for (int m = 0; m < 4; ++m) {
                const int rowu = u.pm * BM + ai * HALF + m * 16;
                const char* sp = (const char*)(ssqp + (size_t)rowu * 20 + (ISQ ? 0 : 12));
                float s = 0.f;
#pragma unroll
                for (int q = 0; q < (ISQ ? 3 : 2); ++q) { const f32x4 t = *(const f32x4*)(sp + o_ss + 16 * q); s += (t[0] + t[1]) + (t[2] + t[3]); }
                const float sc = rsqrtf(s * (ISQ ? (1.f / 384.f) : (1.f / 256.f)) + 1e-6f) * (ISQ ? C2_MLA : 1.f);
#pragma unroll
                for (int bj = 0; bj < 2; ++bj) {
                    const int G = u.pn * 8 + bj * 4 + wc;
                    const bool is_pe = ISQ && (G % 3 == 2);
                    float v[8];
#pragma unroll
                    for (int j = 0; j < 4; ++j) { v[j] = acc[ai][bj][m][0][j]; v[4 + j] = acc[ai][bj][m][1][j]; }
                    if (is_pe) {
                        const char* T = (const char*)(rope + (size_t)rowu * 48);
                        const float sgn = (fq < 2) ? -1.f : 1.f;
#pragma unroll
                        for (int j4 = 0; j4 < 4; ++j4) { const f32x4 cs = *(const f32x4*)(T + o_rp + 16 * j4);
#pragma unroll
                            for (int jj = 0; jj < 2; ++jj) { const int j = 2 * j4 + jj; const float pr = __shfl_xor(v[j], 32); const float c = cs[2 * jj], sn = cs[2 * jj + 1];
                                v[j] = v[j] * c + sgn * pr * sn; } }
                    }
                    u32x4 w; w.x = cvt_pk_bf16(v[0] * sc, v[1] * sc); w.y = cvt_pk_bf16(v[2] * sc, v[3] * sc); w.z = cvt_pk_bf16(v[4] * sc, v[5] * sc); w.w = cvt_pk_bf16(v[6] * sc, v[7] * sc);
                    *(u32x4*)((char*)(O + (size_t)rowu * LDO + G * 32) + o_out) = w;
                }
            }
    }
};
struct EpiOut {
    static constexpr bool PERM = true;
    const float* mod; bf16_t* X1; const float* x;
    __device__ __forceinline__ void operator()(const AccT& acc, const Unit& u, int wr, int wc, int fr, int fq) const {
        unsigned off = ((unsigned)(wr * 64 + fr) * DM + (unsigned)(wc * 32 + 8 * fq)) * 2u;
        asm volatile("" : "+v"(off));
        const float* gt = mod + (u.pm >> 3) * NMOD + 2 * DM;
#pragma unroll
        for (int bj = 0; bj < 2; ++bj) {
            const int cu = u.pn * BM + bj * HALF;
            const f32x4* gp = (const f32x4*)(gt + cu + wc * 32 + 8 * fq);
            const f32x4 g0 = gp[0], g1 = gp[1];
#pragma unroll
            for (int ai = 0; ai < 2; ++ai) {
                f32x4 xs[4][2];
#pragma unroll
                for (int m = 0; m < 4; ++m) { const f32x4* xp = (const f32x4*)((const char*)(x + (size_t)(u.pm * BM + ai * HALF + m * 16) * DM + cu) + 2u * off); xs[m][0] = xp[0]; xs[m][1] = xp[1]; }
#pragma unroll
                for (int m = 0; m < 4; ++m) {
                    const f32x4 v0 = acc[ai][bj][m][0] * g0 + xs[m][0], v1 = acc[ai][bj][m][1] * g1 + xs[m][1];
                    u32x4 w; w.x = cvt_pk_bf16(v0[0], v0[1]); w.y = cvt_pk_bf16(v0[2], v0[3]); w.z = cvt_pk_bf16(v1[0], v1[1]); w.w = cvt_pk_bf16(v1[2], v1[3]);
                    *(u32x4*)((char*)(X1 + (size_t)(u.pm * BM + ai * HALF + m * 16) * DM + cu) + off) = w;
                }
            }
        }
    }
};
__device__ __forceinline__ float swiglu_fast(float gate, float up) {
    gate = fminf(gate, 7.f); up = fminf(fmaxf(up, -7.f), 7.f);
    return gate * __builtin_amdgcn_rcpf(1.f + __builtin_amdgcn_exp2f(-1.702f * 1.4426950408889634f * gate)) * (up + 1.f);
}
struct EpiSwiglu {
    static constexpr bool PERM = true;
    bf16_t* ACT; const float* bgu; const LAS int* texp;
    __device__ __forceinline__ void operator()(const AccT& acc, const Unit& u, int wr, int wc, int fr, int fq) const {
        const int e = texp[u.pm];
        const int c0 = u.pn * 128 + wc * 32 + 8 * fq;
        const f32x4* bp = (const f32x4*)(bgu + (size_t)e * 2 * DFF + 2 * c0);
        const f32x4 b0 = bp[0], b1 = bp[1], b2 = bp[2], b3 = bp[3];
        const float bg[8] = {b0[0], b0[2], b1[0], b1[2], b2[0], b2[2], b3[0], b3[2]}, bu[8] = {b0[1], b0[3], b1[1], b1[3], b2[1], b2[3], b3[1], b3[3]};
        unsigned off = ((unsigned)(wr * 64 + fr) * DFF + (unsigned)(wc * 32 + 8 * fq)) * 2u;
        asm volatile("" : "+v"(off));
#pragma unroll
        for (int ai = 0; ai < 2; ++ai)
#pragma unroll
            for (int m = 0; m < 4; ++m) {
                float a[8];
#pragma unroll
                for (int j = 0; j < 4; ++j) { a[j] = swiglu_fast(acc[ai][0][m][0][j] + bg[j], acc[ai][1][m][0][j] + bu[j]); a[4 + j] = swiglu_fast(acc[ai][0][m][1][j] + bg[4 + j], acc[ai][1][m][1][j] + bu[4 + j]); }
                u32x4 w; w.x = cvt_pk_bf16(a[0], a[1]); w.y = cvt_pk_bf16(a[2], a[3]); w.z = cvt_pk_bf16(a[4], a[5]); w.w = cvt_pk_bf16(a[6], a[7]);
                *(u32x4*)((char*)(ACT + (size_t)(u.pm * BM + ai * HALF + m * 16) * DFF + u.pn * 128) + off) = w;
            }
    }
};
struct EpiDown {
    static constexpr bool PERM = true;
    bf16_t* Y; const float* bd; const float* roww; const LAS int* texp;
    __device__ __forceinline__ void operator()(const AccT& acc, const Unit& u, int wr, int wc, int fr, int fq) const {
        const int e = texp[u.pm];
        unsigned off = ((unsigned)(wr * 64 + fr) * DM + (unsigned)(wc * 32 + 8 * fq)) * 2u, offw = (unsigned)(wr * 64 + fr) * 4u;
        asm volatile("" : "+v"(off), "+v"(offw));
#pragma unroll
        for (int bj = 0; bj < 2; ++bj) {
            const int cu = u.pn * BM + bj * HALF;
            const f32x4* bp = (const f32x4*)(bd + (size_t)e * DM + cu + wc * 32 + 8 * fq);
            const f32x4 b0 = bp[0], b1 = bp[1];
#pragma unroll
            for (int ai = 0; ai < 2; ++ai)
#pragma unroll
                for (int m = 0; m < 4; ++m) {
                    const int ru = u.pm * BM + ai * HALF + m * 16;
                    const float w8 = *(const float*)((const char*)(roww + (size_t)e * MTOK + u.jl * BM + ai * HALF + m * 16) + offw);
                    const f32x4 v0 = (acc[ai][bj][m][0] + b0) * w8, v1 = (acc[ai][bj][m][1] + b1) * w8;
                    u32x4 w; w.x = cvt_pk_bf16(v0[0], v0[1]); w.y = cvt_pk_bf16(v0[2], v0[3]); w.z = cvt_pk_bf16(v1[0], v1[1]); w.w = cvt_pk_bf16(v1[2], v1[3]);
                    *(u32x4*)((char*)(Y + (size_t)ru * DM + cu) + off) = w;
                }
        }
    }
};
}

namespace att {
typedef short v4i16_t __attribute__((ext_vector_type(4)));
constexpr int NSLOT = 3, K_OFF = 0, KSLOT = 12288, V_OFF = NSLOT * KSLOT, VSLOT = 16384, WS_OFF = V_OFF + NSLOT * VSLOT;
constexpr int CONV_OFF = WS_OFF + 8 * 256, CONV_WAVE = 8192;
constexpr int NCHUNK_GU = NEXP * 16 * 128, NCHUNK_DN = NEXP * 16 * 64, NCHUNK = NCHUNK_GU + NCHUNK_DN;
constexpr int CONV_PERIOD = 3;
constexpr float THR = 8.f;
__device__ __forceinline__ int crow(int r, int hi) { return (r & 3) + 8 * (r >> 2) + 4 * hi; }
struct Src { const bf16_t* q; const bf16_t* k1; const bf16_t* k2; const bf16_t* v; int qp, k1p, k2p, vp; };
struct Ring { int s_cur, s_nxt, s_fill; bool pre; };

__device__ __forceinline__ void glds16(const void* gsrc, unsigned lds_dst) { unsigned keep;
    asm volatile("s_mov_b32 %0, m0\n\ts_mov_b32 m0, %2\n\ts_nop 0\n\tglobal_load_lds_dwordx4 %1, off\n\ts_mov_b32 m0, %0" : "=&s"(keep) : "v"(gsrc), "s"(lds_dst) : "memory"); }
template <int DQK, int DV>
__device__ __forceinline__ void issue_tile(LAS unsigned char* lds, int wid, int lane, const Src& S, int t, int slot) {
    constexpr int KCH = DQK / 8, NVP = (DV / 32) * 4, NP = KCH + NVP;
#pragma unroll
    for (int pi = 0; pi < (NP + 7) / 8; ++pi) {
        const int p = wid + 8 * pi;
        if (p < NP) {
            const bf16_t* src; LAS unsigned char* dst;
            if (p < KCH) {
                const int cg = p >> 2, rg = p & 3, row = lane >> 2, ch = (lane & 3) ^ (row >> 2);
                src = (cg < 2) ? S.k1 + (size_t)(t * 64 + rg * 16 + row) * S.k1p + (cg * 4 + ch) * 8 : S.k2 + (size_t)(t * 64 + rg * 16 + row) * S.k2p + ch * 8;
                dst = lds + K_OFF + slot * KSLOT + p * 1024;
            } else {
                const int v = p - KCH, dblk = v >> 2, rg = v & 3;
                src = S.v + (size_t)(t * 64 + 16 * rg + (lane >> 2)) * S.vp + dblk * 32 + (lane & 3) * 8;
                dst = lds + V_OFF + slot * VSLOT + v * 1024;
            }
            glds16(src, (unsigned)__builtin_amdgcn_readfirstlane((int)(unsigned)(uintptr_t)dst));
        }
    }
}
typedef float f32x2_t __attribute__((ext_vector_type(2))); typedef __bf16 bf16x2_t __attribute__((ext_vector_type(2)));
__device__ __forceinline__ unsigned cvtpk_s(float lo, float hi) { f32x2_t v = {lo, hi}; bf16x2_t b = __builtin_convertvector(v, bf16x2_t); return __builtin_bit_cast(unsigned, b); }
__device__ __forceinline__ float max3f(float a, float b, float c) { float r; asm("v_max3_f32 %0, %1, %2, %3" : "=v"(r) : "v"(a), "v"(b), "v"(c)); return r; }
__device__ __forceinline__ float max2f(float a, float b) { float r; asm("v_max_f32_e32 %0, %1, %2" : "=v"(r) : "v"(a), "v"(b)); return r; }
__device__ __forceinline__ float fadd_s(float a, float b) { float r; asm("v_add_f32_e32 %0, %1, %2" : "=v"(r) : "v"(a), "v"(b)); return r; }
template <int DQK>
__device__ __forceinline__ void qk_tile(const LAS unsigned char* Ks, const bf16x8* qr, const f32x16& negm, f32x16& p0, f32x16& p1) {
#pragma unroll
    for (int d0 = 0; d0 < DQK / 16; ++d0) {
        const bf16x8 kb0 = *(const LAS bf16x8*)(Ks + d0 * 2048), kb1 = *(const LAS bf16x8*)(Ks + d0 * 2048 + 512);
        if (d0 == 0) { p0 = __builtin_amdgcn_mfma_f32_32x32x16_bf16(kb0, qr[0], negm, 0, 0, 0); p1 = __builtin_amdgcn_mfma_f32_32x32x16_bf16(kb1, qr[0], negm, 0, 0, 0); }
        else { p0 = __builtin_amdgcn_mfma_f32_32x32x16_bf16(kb0, qr[d0], p0, 0, 0, 0); p1 = __builtin_amdgcn_mfma_f32_32x32x16_bf16(kb1, qr[d0], p1, 0, 0, 0); }
    }
}
template <int DQK>
__device__ __forceinline__ void k_load(const LAS unsigned char* Ks, int koff_e, int koff_o, bf16x8 (&kf)[DQK / 8]) {
#pragma unroll
    for (int d0 = 0; d0 < DQK / 16; ++d0) { const LAS unsigned char* p = Ks + (d0 >> 1) * 4096 + ((d0 & 1) ? koff_o : koff_e);
        kf[2 * d0] = *(const LAS bf16x8*)p; kf[2 * d0 + 1] = *(const LAS bf16x8*)(p + 2048); }
}
template <int DQK>
__device__ __forceinline__ void qk_regs(const bf16x8 (&kf)[DQK / 8], const bf16x8* qr, const f32x16& negm, f32x16& p0, f32x16& p1) {
#pragma unroll
    for (int d0 = 0; d0 < DQK / 16; ++d0) {
        if (d0 == 0) { p0 = __builtin_amdgcn_mfma_f32_32x32x16_bf16(kf[0], qr[0], negm, 0, 0, 0); p1 = __builtin_amdgcn_mfma_f32_32x32x16_bf16(kf[1], qr[0], negm, 0, 0, 0); }
        else { p0 = __builtin_amdgcn_mfma_f32_32x32x16_bf16(kf[2 * d0], qr[d0], p0, 0, 0, 0); p1 = __builtin_amdgcn_mfma_f32_32x32x16_bf16(kf[2 * d0 + 1], qr[d0], p1, 0, 0, 0); }
    }
}
template <int NDV>
__device__ __forceinline__ void softmax_tile(f32x16& c0, f32x16& c1, f32x16& negm, float& mref, float& l, f32x16 (&o)[NDV], LAS float* wsf, int r32, int hi, bool first, u32x4 (&pw)[4]) {
    float a = max3f(c0[0], c0[1], c1[0]), b = max3f(c0[2], c0[3], c1[1]); a = max3f(a, c1[2], c1[3]);
#pragma unroll
    for (int r = 4; r < 16; r += 4) { a = max3f(a, c0[r], c0[r + 1]); b = max3f(b, c0[r + 2], c0[r + 3]); a = max3f(a, c1[r], c1[r + 1]); b = max3f(b, c1[r + 2], c1[r + 3]); }
    float rm = max2f(a, b);
    { auto rr = __builtin_amdgcn_permlane32_swap(__float_as_uint(rm), __float_as_uint(rm), false, false); rm = max2f(__uint_as_float(rr[0]), __uint_as_float(rr[1])); }
    if (first || __any(rm > THR)) {
        const float dl = first ? rm : __builtin_fmaxf(rm, 0.f);
        mref += dl;
        const float f = __builtin_amdgcn_exp2f(-dl); l *= f;
        if (hi == 0) wsf[r32] = f;
#pragma unroll
        for (int r = 0; r < 16; ++r) { c0[r] -= dl; c1[r] -= dl; negm[r] = -mref; }
        if (!first) {
#pragma unroll
            for (int r = 0; r < 16; ++r) { const float fa = wsf[crow(r, hi)];
#pragma unroll
                for (int d = 0; d < NDV; ++d) o[d][r] *= fa; }
        }
    }
    float ps = 0.f, ps2 = 0.f, one = 1.f; asm volatile("" : "+v"(one));
#pragma unroll
    for (int ks = 0; ks < 4; ++ks) {
#pragma unroll
        for (int q = 0; q < 4; ++q) {
            const int r = 8 * (ks & 1) + 2 * q;
            const float ea = __builtin_amdgcn_exp2f(ks < 2 ? c0[r] : c1[r]), eb = __builtin_amdgcn_exp2f(ks < 2 ? c0[r + 1] : c1[r + 1]);
            pw[ks][q] = cvtpk_s(ea, eb);
            ps += ea; ps2 = __builtin_fmaf(eb, one, ps2);
        }
    }
    l += ps + ps2;
}
template <int NDV>
__device__ __forceinline__ void pv_tile(const LAS unsigned char* Vs, const u32x4 (&pw)[4], f32x16 (&o)[NDV]) {
#pragma unroll
    for (int ks = 0; ks < 4; ++ks)
#pragma unroll
        for (int d0 = 0; d0 < NDV; ++d0) {
            const v4i16_t lo = __builtin_amdgcn_ds_read_tr16_b64_v4i16((LAS v4i16_t*)(Vs + (d0 * 4 + ks) * 1024));
            const v4i16_t hh = __builtin_amdgcn_ds_read_tr16_b64_v4i16((LAS v4i16_t*)(Vs + (d0 * 4 + ks) * 1024 + 512));
            const bf16x8 vf = (bf16x8){lo[0], lo[1], lo[2], lo[3], hh[0], hh[1], hh[2], hh[3]};
            o[d0] = __builtin_amdgcn_mfma_f32_32x32x16_bf16(__builtin_bit_cast(bf16x8, pw[ks]), vf, o[d0], 0, 0, 0);
        }
}

struct Conv { const float* wgu; const float* wdn; bf16_t* WguT; bf16_t* WdT; int gw, ngw, k, c, pend0, pend1, tick, staged; };
__device__ __forceinline__ void conv_addr(const Conv& cv, int id, const float*& W, int& ldw, bf16_t*& WT, int& kb, int& cb, bool& gu) {
    if (id < NCHUNK_GU) { const int e = id >> 11, r = id & 2047; kb = r >> 7; cb = r & 127; W = cv.wgu + (size_t)e * DM * 2 * DFF; ldw = 2 * DFF; WT = cv.WguT + (size_t)e * 2 * DFF * DM; gu = true; }
    else { const int id2 = id - NCHUNK_GU, e = id2 >> 10, r = id2 & 1023; kb = r >> 6; cb = r & 63; W = cv.wdn + (size_t)e * DFF * DM; ldw = DM; WT = cv.WdT + (size_t)e * DM * DFF; gu = false; }
}
__device__ __forceinline__ void conv_step(Conv& cv, LAS unsigned char* cs, int lane, bool load_next = true) {
    const int bsel = cv.c & 1; ++cv.c;
    LAS unsigned char* cf = cs + bsel * 4096;
    const int pend = bsel ? cv.pend1 : cv.pend0;
    if (pend >= 0) {
        const float* W; int ldw, kb, cb; bf16_t* WT; bool gu; conv_addr(cv, pend, W, ldw, WT, kb, cb, gu);
        f32x4 v[4];
#pragma unroll
        for (int i = 0; i < 4; ++i) v[i] = *(const LAS f32x4*)(cf + lane * 64 + 16 * i);
        asm volatile("s_waitcnt lgkmcnt(0)" : "+v"(v[0]), "+v"(v[1]), "+v"(v[2]), "+v"(v[3]) :: "memory");
#pragma unroll
        for (int i = 0; i < 4; ++i) { u32x2 w; w.x = cvtpk_s(v[i][0], v[i][1]); w.y = cvtpk_s(v[i][2], v[i][3]); *(LAS u32x2*)(cf + lane * 40 + 8 * i) = w; }
        asm volatile("s_waitcnt lgkmcnt(0)" ::: "memory");
        const int g = lane >> 4, i16 = lane & 15, q = i16 >> 2, p = i16 & 3;
        const int c = cb * 16 + i16, row = gu ? ((c >> 8) * 256 + (c & 1) * 128 + ((c & 255) >> 1)) : c;
#pragma unroll
        for (int j = 0; j < 2; ++j) { const int seg = g + 4 * j;
            const LAS unsigned char* a = cf + (8 * seg + q) * 40 + 8 * p;
            const v4i16_t lo = __builtin_amdgcn_ds_read_tr16_b64_v4i16((LAS v4i16_t*)a), hh = __builtin_amdgcn_ds_read_tr16_b64_v4i16((LAS v4i16_t*)(a + 160));
            u32x4 o; o.x = (unsigned)(unsigned short)lo[0] | ((unsigned)(unsigned short)lo[1] << 16); o.y = (unsigned)(unsigned short)lo[2] | ((unsigned)(unsigned short)lo[3] << 16);
            o.z = (unsigned)(unsigned short)hh[0] | ((unsigned)(unsigned short)hh[1] << 16); o.w = (unsigned)(unsigned short)hh[2] | ((unsigned)(unsigned short)hh[3] << 16);
            *(u32x4*)((char*)(WT + kb * 64) + (unsigned)(row * DM + 8 * seg) * 2u) = o; }
        asm volatile("s_waitcnt lgkmcnt(0)" ::: "memory");
    }
    int np = -1;
    if (load_next) {
        const int id = cv.k * cv.ngw + cv.gw; ++cv.k;
        if (id < NCHUNK) { const float* W; int ldw, kb, cb; bf16_t* WT; bool gu; conv_addr(cv, id, W, ldw, WT, kb, cb, gu);
            const char* src = (const char*)(W + (size_t)kb * 64 * ldw + cb * 16); const unsigned loff = ((unsigned)(lane >> 2) * (unsigned)ldw + (unsigned)(lane & 3) * 4u) * 4u;
#pragma unroll
            for (int i = 0; i < 4; ++i) glds16(src + (size_t)(16 * i) * ldw * 4 + loff, (unsigned)__builtin_amdgcn_readfirstlane((int)(unsigned)(uintptr_t)(cf + i * 1024)));
            np = id; cv.staged += 4; }
    }
    if (bsel) cv.pend1 = np; else cv.pend0 = np;
}
__device__ __forceinline__ void conv_drain(Conv& cv, LAS unsigned char* cs, int lane) {
    for (;;) { asm volatile("s_waitcnt vmcnt(0)" ::: "memory"); conv_step(cv, cs, lane); if (cv.pend0 < 0 && cv.pend1 < 0) break; }
}

template <int DQK, int DV, bool CONV>
__device__ __forceinline__ float attn_pass(LAS unsigned char* lds, int wid, int lane, const Src& S, int NT, int my_nt, f32x16 (&o)[DV / 32], Ring& R, const Src& nS, int next_kind, Conv& cv) {
    constexpr int ND0 = DQK / 16, NDV = DV / 32;
    asm volatile("" : "+v"(lane));
    const int r32 = lane & 31, hi = lane >> 5;
    LAS float* wsf = (LAS float*)(lds + WS_OFF + wid * 256);
    if (!R.pre) { issue_tile<DQK, DV>(lds, wid, lane, S, 0, R.s_cur); issue_tile<DQK, DV>(lds, wid, lane, S, 1, R.s_nxt); }
    bf16x8 qr[ND0];
#pragma unroll
    for (int d0 = 0; d0 < ND0; ++d0) qr[d0] = *(const bf16x8*)(S.q + (size_t)r32 * S.qp + d0 * 16 + hi * 8);
    f32x16 negm;
#pragma unroll
    for (int r = 0; r < 16; ++r) negm[r] = 0.f;
#pragma unroll
    for (int d = 0; d < NDV; ++d)
#pragma unroll
        for (int r = 0; r < 16; ++r) o[d][r] = 0.f;
    float mref = 0.f, l = 0.f;
    const int koff_e = (r32 >> 4) * 1024 + (r32 & 15) * 64 + ((hi ^ ((r32 & 15) >> 2)) * 16), koff_o = koff_e ^ 32, voff = ((lane >> 4) & 1) * 32 + (lane & 3) * 8 + (4 * hi + ((lane & 15) >> 2)) * 64;
    asm volatile("s_waitcnt vmcnt(0)" ::: "memory");
    cv.staged = 0;
#pragma unroll
    for (int d0 = 0; d0 < ND0; ++d0) asm volatile("" : "+v"(qr[d0]));
    __syncthreads();
    f32x16 c0, c1;
    int s_cur = R.s_cur, s_nxt = R.s_nxt, s_fill = R.s_fill;
    { bf16x8 kf0[DQK / 8]; k_load<DQK>(lds + K_OFF + s_cur * KSLOT, koff_e, koff_o, kf0); qk_regs<DQK>(kf0, qr, negm, c0, c1); }
    for (int t = 0; t < NT; ++t) {
        if (CONV && cv.staged == 4) asm volatile("s_waitcnt vmcnt(4)" ::: "memory");
        else asm volatile("s_waitcnt vmcnt(0)" ::: "memory");
        cv.staged = 0;
        __syncthreads();
        if (t + 2 < NT) { issue_tile<DQK, DV>(lds, wid, lane, S, t + 2, s_fill); if ((PROBE_REP >> 16) & 1) issue_tile<DQK, DV>(lds, wid, lane, S, t + 2, s_fill); }
        else if (next_kind == 1) issue_tile<64, 128>(lds, wid, lane, nS, t + 2 - NT, s_fill);
        else if (next_kind == 2) issue_tile<96, 64>(lds, wid, lane, nS, t + 2 - NT, s_fill);
        if constexpr (CONV) { if (cv.tick != 0) conv_step(cv, lds + CONV_OFF + wid * CONV_WAVE, lane); cv.tick = (cv.tick == CONV_PERIOD - 1) ? 0 : cv.tick + 1; }
        if ((PROBE_REP >> 19) & 1) __syncthreads();
        if (t < my_nt) {
            u32x4 pw[4]; bf16x8 kf[DQK / 8];
            k_load<DQK>(lds + K_OFF + s_nxt * KSLOT, koff_e, koff_o, kf);
            asm volatile("s_nop 15\n\ts_nop 7" : "+v"(c0), "+v"(c1));
            softmax_tile<NDV>(c0, c1, negm, mref, l, o, wsf, r32, hi, t == 0, pw);
            qk_regs<DQK>(kf, qr, negm, c0, c1);
            if ((PROBE_REP >> 18) & 1) { asm volatile("" : "+v"(c0), "+v"(c1)); qk_regs<DQK>(kf, qr, negm, c0, c1); }
            pv_tile<NDV>(lds + V_OFF + s_cur * VSLOT + voff, pw, o);
            if ((PROBE_REP >> 17) & 1) { u32x4 pz[4];
#pragma unroll
                for (int k = 0; k < 4; ++k) { pz[k] = (u32x4){0u, 0u, 0u, 0u}; asm volatile("" : "+v"(pz[k])); }
                pv_tile<NDV>(lds + V_OFF + s_cur * VSLOT + voff, pz, o); }
        }
        { const int tmp_ = s_cur; s_cur = s_nxt; s_nxt = s_fill; s_fill = tmp_; }
    }
    __syncthreads();
    R.s_cur = s_cur; R.s_nxt = s_nxt; R.s_fill = s_fill; R.pre = (next_kind != 0);
    { auto rr = __builtin_amdgcn_permlane32_swap(__float_as_uint(l), __float_as_uint(l), false, false); l = __uint_as_float(rr[0]) + __uint_as_float(rr[1]); }
    return l;
}

__device__ __forceinline__ void attn_phase(LAS unsigned char* lds, int vcu, int G, const bf16_t* PROJ, const bf16_t* QMLA, const bf16_t* KV, bf16_t* ATT, const float* g_sub, float lam, unsigned* o1g, Conv& cv) {
    const int tid = threadIdx.x, wid = __builtin_amdgcn_readfirstlane(tid >> 6); int lane = tid & 63;
    LAS float* wsf = (LAS float*)(lds + WS_OFF + wid * 256);
    unsigned* o1b = o1g + (size_t)blockIdx.x * 16384 + wid * 2048;
    const int nd = vcu < 256 ? (256 - vcu + G - 1) / G : 0, nm = vcu < 512 ? (512 - vcu + G - 1) / G : 0, npass = 4 * nd + 2 * nm;
    Ring R; R.s_cur = 0; R.s_nxt = 1; R.s_fill = 2; R.pre = false;
#define ATT_DECODE(P, KIND, SRC, NTv, MYNT, RQ, HH, CC) do { \
        if ((P) < 4 * nd) { const int it_ = vcu + ((P) >> 2) * G, half_ = ((P) >> 1) & 1, c_ = (P) & 1, bh_ = it_ >> 2, s_ = it_ & 3, b_ = bh_ >> 2, h_ = bh_ & 3, qb_ = half_ ? 7 - s_ : s_; \
            const size_t r0_ = (size_t)b_ * SEQ, rq_ = r0_ + qb_ * 256 + wid * 32; \
            KIND = 1; NTv = 4 * qb_ + 4; MYNT = 4 * qb_ + (wid >> 1) + 1; RQ = rq_; HH = h_; CC = c_; \
            SRC.qp = PROJ_LD; SRC.k1p = PROJ_LD; SRC.k2p = PROJ_LD; SRC.vp = PROJ_LD; SRC.v = PROJ + r0_ * PROJ_LD + P_DV + h_ * 128; \
            SRC.q = PROJ + rq_ * PROJ_LD + P_DQ + h_ * 128 + c_ * 64; SRC.k1 = PROJ + r0_ * PROJ_LD + P_DK + h_ * 128 + c_ * 64; SRC.k2 = SRC.k1; } \
        else if ((P) < npass) { const int q_ = (P) - 4 * nd, it_ = vcu + (q_ >> 1) * G, half_ = q_ & 1, bh_ = it_ >> 2, s_ = it_ & 3, b_ = bh_ >> 3, h_ = bh_ & 7, qb_ = half_ ? 7 - s_ : s_; \
            const size_t r0_ = (size_t)b_ * SEQ, rq_ = r0_ + qb_ * 256 + wid * 32; \
            KIND = 2; NTv = 4 * qb_ + 4; MYNT = 4 * qb_ + (wid >> 1) + 1; RQ = rq_; HH = h_; CC = 0; \
            SRC.q = QMLA + rq_ * 768 + h_ * 96; SRC.qp = 768; SRC.k1 = KV + r0_ * 1024 + h_ * 128; SRC.k1p = 1024; SRC.k2 = PROJ + r0_ * PROJ_LD + P_KPE; SRC.k2p = PROJ_LD; \
            SRC.v = KV + r0_ * 1024 + h_ * 128 + 64; SRC.vp = 1024; } \
        else { KIND = 0; } } while (0)
    for (int p = 0; p < npass; ++p) {
        int kind, NT, my_nt, h, c, nkind, nNT, nmy, nh, nc; size_t rq, nrq; Src S, nS;
        ATT_DECODE(p, kind, S, NT, my_nt, rq, h, c);
        nS = S; ATT_DECODE(p + 1, nkind, nS, nNT, nmy, nrq, nh, nc);
        (void)nNT; (void)nmy; (void)nrq; (void)nh; (void)nc;
        if (kind == 1) {
            f32x16 o[4];
            const float l = attn_pass<64, 128, false>(lds, wid, lane, S, NT, my_nt, o, R, nS, nkind, cv);
            asm volatile("" : "+v"(lane)); const int r32 = lane & 31, hi = lane >> 5; unsigned* o1s = o1b + lane;
            if (hi == 0) wsf[32 + r32] = 1.f / l;
            if (c == 0) {
#pragma unroll
                for (int r = 0; r < 16; r += 2) { const float rl0 = wsf[32 + crow(r, hi)], rl1 = wsf[32 + crow(r + 1, hi)];
#pragma unroll
                    for (int d = 0; d < 4; ++d) o1s[(d * 8 + (r >> 1)) * 64] = pk2(o[d][r] * rl0, o[d][r + 1] * rl1); }
            } else {
                LAS unsigned char* stg = lds + CONV_OFF + wid * CONV_WAVE;
                float gs[4];
#pragma unroll
                for (int d = 0; d < 4; ++d) gs[d] = g_sub[d * 32 + r32];
#pragma unroll
                for (int r = 0; r < 16; ++r) { const float rl = wsf[32 + crow(r, hi)];
                    float ss = 0.f; float v[4];
#pragma unroll
                    for (int d = 0; d < 4; ++d) { const unsigned w = o1s[(d * 8 + (r >> 1)) * 64]; const float o1 = __builtin_bit_cast(float, (r & 1) ? (w & 0xffff0000u) : (w << 16));
                        v[d] = o1 - lam * (o[d][r] * rl); ss += v[d] * v[d]; }
                    ss += __shfl_xor(ss, 1); ss += __shfl_xor(ss, 2); ss += __shfl_xor(ss, 4); ss += __shfl_xor(ss, 8); ss += __shfl_xor(ss, 16);
                    const float rinv = rsqrtf(ss * (1.f / 128.f) + 1e-5f) * (1.f - LAMBDA_INIT);
#pragma unroll
                    for (int d = 0; d < 4; ++d) *(LAS bf16_t*)(stg + crow(r, hi) * 256 + (d * 32 + r32) * 2) = (bf16_t)f2bf(v[d] * rinv * gs[d]); }
                asm volatile("s_waitcnt lgkmcnt(0)" ::: "memory");
#pragma unroll
                for (int j = 0; j < 8; ++j) { const int idx = lane + 64 * j, row = idx >> 4, ch = idx & 15;
                    const u32x4 vv = *(const LAS u32x4*)(stg + row * 256 + ch * 16);
                    *(u32x4*)(ATT + (rq + row) * DM + 512 + h * 128 + ch * 8) = vv; }
                asm volatile("s_waitcnt lgkmcnt(0)" ::: "memory");
            }
        } else {
            f32x16 o[2];
            const float l = attn_pass<96, 64, true>(lds, wid, lane, S, NT, my_nt, o, R, nS, nkind, cv);
            asm volatile("" : "+v"(lane)); const int r32 = lane & 31, hi = lane >> 5;
            if (hi == 0) wsf[32 + r32] = 1.f / l;
            {
                LAS unsigned char* stg = lds + V_OFF + R.s_fill * VSLOT + wid * 2048;
#pragma unroll
                for (int hf = 0; hf < 2; ++hf) {
#pragma unroll
                    for (int r8 = 0; r8 < 8; ++r8) { const int r = 8 * hf + r8; const float rl = wsf[32 + crow(r, hi)];
#pragma unroll
                        for (int d = 0; d < 2; ++d) *(LAS bf16_t*)(stg + (crow(r, hi) - 16 * hf) * 128 + (d * 32 + r32) * 2) = (bf16_t)f2bf(o[d][r] * rl); }
                    asm volatile("s_waitcnt lgkmcnt(0)" ::: "memory");
#pragma unroll
                    for (int j = 0; j < 2; ++j) { const int idx = lane + 64 * j, row = idx >> 3, ch = idx & 7;
                        const u32x4 vv = *(const LAS u32x4*)(stg + row * 128 + ch * 16);
                        *(u32x4*)(ATT + (rq + 16 * hf + row) * DM + h * 64 + ch * 8) = vv; }
                    asm volatile("s_waitcnt lgkmcnt(0)" ::: "memory");
                }
            }
        }
    }
#undef ATT_DECODE
    conv_drain(cv, lds + CONV_OFF + wid * CONV_WAVE, lane);
}
}

constexpr int RING_BYTES = 155648;
constexpr int LDSCTL_OFF = RING_BYTES;
constexpr int LDS_TEXP = RING_BYTES + 256;
constexpr int LDS_IDX = RING_BYTES + 4096;
constexpr int LDS_BYTES = 163840;
constexpr int NWAVES = 8;
constexpr int N_PHASES = 11;

struct MkArgs {
    const float* in[25]; float* out; unsigned char* ws; long long ph_lo_hi;
};
static_assert(sizeof(MkArgs) == 28 * 8, "MkArgs has padding");

__device__ __forceinline__ int src_col_win(int nd) { return nd < 640 ? nd : (nd < 2176 ? nd + 32 : (nd < 2208 ? nd - 2176 + 640 : -1)); }
__device__ __forceinline__ int src_col_gu(int nd) { const int pn = nd >> 8, r = nd & 255; return r < 128 ? 2 * (128 * pn + r) : 2 * (128 * pn + r - 128) + 1; }

template <int MAP>
__device__ __forceinline__ void p0_tr_item(const float* __restrict__ W, int ldw, int K, bf16_t* WT, int n0, int k0, const float* __restrict__ g, LAS float* scr, int lane) {
    const int nd = n0 + (lane & 31);
    const int sc = MAP == 0 ? nd : (MAP == 1 ? src_col_win(nd) : src_col_gu(nd));
#pragma unroll 8
    for (int i = 0; i < 32; ++i) { const int kk = 2 * i + (lane >> 5); float v = 0.f; if (sc >= 0) v = W[(size_t)(k0 + kk) * ldw + sc]; if (g) v *= g[k0 + kk]; scr[kk * 33 + (lane & 31)] = v; }
    asm volatile("s_waitcnt lgkmcnt(0)" ::: "memory");
    const int c = lane & 7;
#pragma unroll
    for (int j = 0; j < 4; ++j) { const int n = (lane >> 3) + 8 * j; const LAS float* s = scr + (8 * c) * 33 + n;
        u32x4 o; o.x = pk2(s[0 * 33], s[1 * 33]); o.y = pk2(s[2 * 33], s[3 * 33]); o.z = pk2(s[4 * 33], s[5 * 33]); o.w = pk2(s[6 * 33], s[7 * 33]);
        *(u32x4*)(WT + (size_t)(n0 + n) * K + k0 + 8 * c) = o; }
    asm volatile("s_waitcnt lgkmcnt(0)" ::: "memory");
}
__global__ void __launch_bounds__(NWAVES * 64, 2) mk_fwd(MkArgs args) {
    extern __shared__ __attribute__((aligned(16))) unsigned char lds_raw[];
    LAS unsigned char* lds = (LAS unsigned char*)lds_raw;
    const int tid = threadIdx.x, lane = tid & 63, wave = __builtin_amdgcn_readfirstlane(tid >> 6);
    const int G = gridDim.x; const int bx = blockIdx.x; const int vcu = (G % 8 == 0) ? (bx % 8) * (G / 8) + bx / 8 : bx;
    const int gw = vcu * NWAVES + wave, NGW = G * NWAVES;
    unsigned char* ws = args.ws;
    unsigned* ctl = (unsigned*)(ws + F_CTL);
    const int ph_lo = (int)(args.ph_lo_hi & 0xffff), ph_hi = (int)((args.ph_lo_hi >> 16) & 0xffff), li = (int)((args.ph_lo_hi >> 32) & 0xffff);
    const float* x = args.in[0]; const float* cvec = args.in[1]; const int* pos = (const int*)args.in[2];
    const float* w_ada = args.in[3]; const float* b_ada = args.in[4]; const float* g1 = args.in[5];
    const float* w_in = args.in[6]; const float* g_q = args.in[7]; const float* w_uq = args.in[8];
    const float* g_kv = args.in[9]; const float* w_ukv = args.in[10];
    const float* g_sub = args.in[15]; const float* w_out = args.in[16]; const float* g2 = args.in[17];
    const float* w_r = args.in[18]; const float* b_r = args.in[19]; const float* w_gu = args.in[20]; const float* b_gu = args.in[21];
    const float* w_dn = args.in[22]; const float* b_dn = args.in[23]; const float* g_fin = args.in[24];
    float* mod = (float*)(ws + F_MOD); float* lamp = (float*)(ws + F_MISC); float* rope = (float*)(ws + F_ROPE); float* ssqp = (float*)(ws + F_SSQP);
    bf16_t* WinT = (bf16_t*)(ws + F_WIN); bf16_t* WuqT = (bf16_t*)(ws + F_WUQ); bf16_t* WukvT = (bf16_t*)(ws + F_WUKV); bf16_t* WoutT = (bf16_t*)(ws + F_WOUT);
    bf16_t* WguT = (bf16_t*)(ws + F_WGU); bf16_t* WdT = (bf16_t*)(ws + F_WD);
    bf16_t* H1 = (bf16_t*)(ws + F_H1); bf16_t* PROJ = (bf16_t*)(ws + F_PROJ);

    for (int u = tid; u < 64; u += NWAVES * 64) ((LAS unsigned*)(lds + LDSCTL_OFF))[u] = 0u;
    __syncthreads();
    XcdBarrier bar = xcd_barrier_post(ctl + CW_BAR + li * XCD_BAR_WORDS, (volatile LAS unsigned*)(lds + LDSCTL_OFF) + 8);
#ifndef PROBE_REP
#define PROBE_REP 0
#endif
#define REPS(k) (((PROBE_REP >> (k)) & 1) ? 2 : 1)
#define IN(k) (ph_lo <= (k) && (k) < ph_hi)
#define SEAM(k) do { if (IN(k) && IN((k) + 1)) xcd_barrier(bar); } while (0)

    if (IN(0)) {
        LAS float* scr = (LAS float*)(lds + wave * 16384);
        float* modp = (float*)(ws + F_MODP); unsigned* modc = ctl + CW_MODC;
        for (int it = gw; it < 96 * 16; it += NGW) {
            const int cb = it % 96, kc = it / 96;
#pragma unroll
            for (int j = 0; j < 16; ++j) { const int kk = (lane >> 4) + 4 * j; const float cv = cvec[(lane & 15) * DM + kc * 64 + kk]; scr[kk * 16 + (lane & 15)] = cv / (1.f + __expf(-cv)); }
            asm volatile("s_waitcnt lgkmcnt(0)" ::: "memory");
            float acc[16];
#pragma unroll
            for (int b = 0; b < 16; ++b) acc[b] = 0.f;
            const float* wp = w_ada + (size_t)(kc * 64) * NMOD + cb * 64 + lane;
#pragma unroll 1
            for (int k16 = 0; k16 < 64; k16 += 16) {
                float wv[16];
#pragma unroll
                for (int kk = 0; kk < 16; ++kk) wv[kk] = wp[(size_t)(k16 + kk) * NMOD];
#pragma unroll
                for (int kk = 0; kk < 16; ++kk) { const float w = wv[kk];
#pragma unroll
                    for (int b4 = 0; b4 < 4; ++b4) { const f32x4 s4 = *(const LAS f32x4*)(scr + (k16 + kk) * 16 + 4 * b4); acc[4 * b4] += s4[0] * w; acc[4 * b4 + 1] += s4[1] * w; acc[4 * b4 + 2] += s4[2] * w; acc[4 * b4 + 3] += s4[3] * w; } }
            }
            float* pp = modp + (size_t)kc * 16 * NMOD + cb * 64 + lane;
#pragma unroll
            for (int b = 0; b < 16; ++b) __hip_atomic_store(pp + b * NMOD, acc[b], __ATOMIC_RELAXED, __HIP_MEMORY_SCOPE_AGENT);
            asm volatile("s_waitcnt vmcnt(0)" ::: "memory");
            unsigned old = 0u;
            if (lane == 0) old = __hip_atomic_fetch_add(modc + cb, 1u, __ATOMIC_RELAXED, __HIP_MEMORY_SCOPE_AGENT);
            old = (unsigned)__builtin_amdgcn_readfirstlane((int)old);
            if (old == 15u) {
                const float bias = b_ada[cb * 64 + lane];
#pragma unroll
                for (int b = 0; b < 16; ++b) acc[b] = bias;
                const float* qq = modp + cb * 64 + lane;
#pragma unroll 1
                for (int k = 0; k < 16; k += 4) {
                    float t[4][16];
#pragma unroll
                    for (int kk = 0; kk < 4; ++kk)
#pragma unroll
                        for (int b = 0; b < 16; ++b) t[kk][b] = __hip_atomic_load(qq + (size_t)((k + kk) * 16 + b) * NMOD, __ATOMIC_RELAXED, __HIP_MEMORY_SCOPE_AGENT);
#pragma unroll
                    for (int kk = 0; kk < 4; ++kk)
#pragma unroll
                        for (int b = 0; b < 16; ++b) acc[b] += t[kk][b];
                }
#pragma unroll
                for (int b = 0; b < 16; ++b) mod[b * NMOD + cb * 64 + lane] = acc[b];
            }
            asm volatile("s_waitcnt lgkmcnt(0)" ::: "memory");
        }
        for (int rep = 0; rep < REPS(13); ++rep)
        for (int idx = gw * 64 + lane; idx < MTOK * 4; idx += NGW * 64) {
            const int m = idx >> 2, q6 = (idx & 3) * 6;
            const float pf = (float)pos[m];
            float cs[12];
#pragma unroll
            for (int j = 0; j < 6; ++j) { const int f = q6 + j;
                const float invf = f < 16 ? INVF16[f] : INVF8[f - 16];
                const float ang = pf * invf;
                double rev = (double)ang * 0.15915494309189533577; rev -= rint(rev);
                cs[2 * j] = __builtin_amdgcn_cosf((float)rev); cs[2 * j + 1] = __builtin_amdgcn_sinf((float)rev); }
            f32x4* rp = (f32x4*)(rope + (size_t)m * 48 + 2 * q6);
#pragma unroll
            for (int j = 0; j < 3; ++j) rp[j] = (f32x4){cs[4 * j], cs[4 * j + 1], cs[4 * j + 2], cs[4 * j + 3]};
        }
        if (gw == 0) {
            const float a = wave_sum(args.in[11][lane] * args.in[12][lane]), b = wave_sum(args.in[13][lane] * args.in[14][lane]);
            if (lane == 0) *lamp = expf(a) - expf(b) + LAMBDA_INIT;
        }
        constexpr int I_IN = 16 * 72, I_UQ = 6 * 24, I_UKV = 4 * 32, I_OUT = 16 * 32;
        constexpr int NITEMS = I_IN + I_UQ + I_UKV + I_OUT;
        for (int rep = 0; rep < REPS(0); ++rep)
        for (int it = gw; it < NITEMS; it += NGW) {
            int r = it;
            if (r < I_IN) { p0_tr_item<1>(w_in, INCOLS, DM, WinT, (r % 72) * 32, (r / 72) * 64, nullptr, scr, lane); continue; } r -= I_IN;
            if (r < I_UQ) { p0_tr_item<0>(w_uq, 768, QRANK, WuqT, (r % 24) * 32, (r / 24) * 64, g_q, scr, lane); continue; } r -= I_UQ;
            if (r < I_UKV) { p0_tr_item<0>(w_ukv, 1024, KVRANK, WukvT, (r % 32) * 32, (r / 32) * 64, g_kv, scr, lane); continue; } r -= I_UKV;
            p0_tr_item<0>(w_out, DM, DM, WoutT, (r % 32) * 32, (r / 32) * 64, nullptr, scr, lane);
        }
    }
    SEAM(0);
    if (IN(1)) {
        for (int rep = 0; rep < REPS(1); ++rep) {
        const int rpw = (MTOK + NGW - 1) / NGW, m0 = gw * rpw, m1 = (m0 + rpw < MTOK) ? m0 + rpw : MTOK;
        f32x4 gv[4], sc[4], sh[4]; int bcur = -1;
#pragma unroll
        for (int j = 0; j < 4; ++j) gv[j] = *(const f32x4*)(g1 + 4 * lane + 256 * j);
        for (int m = m0; m < m1; m += 2) {
            const bool two = (m + 1 < m1);
            const f32x4* xr0 = (const f32x4*)(x + (size_t)m * DM) + lane; const f32x4* xr1 = (const f32x4*)(x + (size_t)(two ? m + 1 : m) * DM) + lane;
            f32x4 v0[4], v1[4];
#pragma unroll
            for (int j = 0; j < 4; ++j) { v0[j] = xr0[64 * j]; v1[j] = xr1[64 * j]; }
#pragma unroll
            for (int rr = 0; rr < 2; ++rr) {
                if (rr == 1 && !two) break;
                const int mm = m + rr, b = mm / SEQ;
                if (b != bcur) { bcur = b;
#pragma unroll
                    for (int j = 0; j < 4; ++j) { sc[j] = *(const f32x4*)(mod + b * NMOD + DM + 4 * lane + 256 * j); sh[j] = *(const f32x4*)(mod + b * NMOD + 4 * lane + 256 * j); } }
                float ssum = 0.f;
#pragma unroll
                for (int j = 0; j < 4; ++j) { const f32x4 t = rr ? v1[j] : v0[j]; ssum += (t[0] * t[0] + t[1] * t[1]) + (t[2] * t[2] + t[3] * t[3]); }
                const float rinv = rsqrtf(wave_sum(ssum) * (1.f / DM) + 1e-6f);
                unsigned long long* o8 = (unsigned long long*)(H1 + (size_t)mm * DM) + lane;
#pragma unroll
                for (int j = 0; j < 4; ++j) { const f32x4 t = rr ? v1[j] : v0[j]; f32x4 o;
#pragma unroll
                    for (int q = 0; q < 4; ++q) o[q] = t[q] * rinv * gv[j][q] * (1.f + sc[j][q]) + sh[j][q];
                    o8[64 * j] = (unsigned long long)pk2(o[0], o[1]) | ((unsigned long long)pk2(o[2], o[3]) << 32); }
            }
        }
        }
    }
    SEAM(1);
    if (IN(2)) {
        pg8::Gemm g{H1, WinT, DM, DM}; pg8::StaticOrder S; S.init(MTOK, PROJ_LD, G, bx, REPS(2));
        pg8::EpiProj E{PROJ, rope, ssqp};
        pg8::gemm_phase<pg8::EpiProj, pg8::StaticOrder, true, true>(lds, g, S, E);
    }
    SEAM(2);
    if (IN(3)) {
        bf16_t* QMLA = (bf16_t*)(ws + F_QMLA); bf16_t* KV = (bf16_t*)(ws + F_KV);
        { pg8::Gemm g{PROJ + P_CQ, WuqT, PROJ_LD, QRANK}; pg8::StaticOrder S; S.init(MTOK, 768, G, bx, REPS(3));
          pg8::EpiUp<true> E{QMLA, rope, ssqp};
          pg8::gemm_phase<pg8::EpiUp<true>, pg8::StaticOrder, true, true>(lds, g, S, E); }
        { pg8::Gemm g{PROJ + P_CKV, WukvT, PROJ_LD, KVRANK}; pg8::StaticOrder S; S.init(MTOK, 1024, G, bx, REPS(3));
          pg8::EpiUp<false> E{KV, rope, ssqp};
          pg8::gemm_phase<pg8::EpiUp<false>, pg8::StaticOrder, true, true>(lds, g, S, E); }
    }
    SEAM(3);
    if (IN(4)) for (int rep = 0; rep < REPS(4); ++rep) {
        att::Conv cv; cv.wgu = w_gu; cv.wdn = w_dn; cv.WguT = WguT; cv.WdT = WdT; cv.gw = gw; cv.ngw = NGW; cv.k = 0; cv.c = 0; cv.pend0 = -1; cv.pend1 = -1; cv.tick = 0; cv.staged = 0;
        att::attn_phase(lds, vcu, G, PROJ, (const bf16_t*)(ws + F_QMLA), (const bf16_t*)(ws + F_KV), (bf16_t*)(ws + F_ATT), g_sub, *lamp, (unsigned*)(ws + F_O1S), cv);
    }
    SEAM(4);
    bf16_t* MIXG = (bf16_t*)(ws + F_X1);
    if (IN(5)) {
        pg8::Gemm g{(const bf16_t*)(ws + F_ATT), WoutT, DM, DM}; pg8::StaticOrder S; S.init(MTOK, DM, G, bx, REPS(5));
        pg8::EpiOut E{mod, MIXG, x};
        pg8::gemm_phase<pg8::EpiOut, pg8::StaticOrder, true, true>(lds, g, S, E);
    }
    SEAM(5);
    bf16_t* H2 = (bf16_t*)(ws + F_H2);
    int* topi = (int*)(ws + F_TOPI); float* topw = (float*)(ws + F_TOPW); int* tpos = (int*)(ws + F_TPOS);
    unsigned* ecnt = ctl + CW_CNT;
    if (IN(6)) {
        constexpr int HP = 1028;
        LAS float* hrow = (LAS float*)lds;
        LAS float* red = (LAS float*)(lds + 16 * HP * 4);
        LAS int* lcnt = (LAS int*)(lds + 16 * HP * 4 + 16384);
        LAS int* gbs = lcnt + 32;
        LAS int* lsel = lcnt + 64;
        LAS int* lpos = lsel + 1024;
        LAS float* lwt = (LAS float*)(lpos + 1024);
        int* list = (int*)(ws + F_LIST); float* lw = (float*)(ws + F_LW);
        const int li = lane & 15, lq = lane >> 4;
        float wreg[32][2];
#pragma unroll
        for (int sidx = 0; sidx < 32; ++sidx)
#pragma unroll
            for (int nb = 0; nb < 2; ++nb) wreg[sidx][nb] = w_r[(size_t)(128 * wave + 4 * sidx + lq) * NEXP + nb * 16 + li];
        const int e = lane & 31;
        const float be = b_r[e];
        if (tid < 32) lcnt[tid] = 0;
        __syncthreads();
        int nloc = 0;
        const int ntw = (MTOK / 16 + G - 1) / G, tl0 = vcu * ntw, tl1 = (tl0 + ntw < MTOK / 16) ? tl0 + ntw : MTOK / 16;
        f32x4 gv2[4], sc2[4], sh2[4]; int bcur = -1;
#pragma unroll
        for (int j = 0; j < 4; ++j) gv2[j] = *(const f32x4*)(g2 + 4 * lane + 256 * j);
        f32x4 v[2][4]; u32x2 mwv[2][4];
#define P6_LOAD(TL) do { _Pragma("unroll") for (int rr = 0; rr < 2; ++rr) { const int m_ = (TL) * 16 + 2 * wave + rr; \
            const u32x2* mr = (const u32x2*)(MIXG + (size_t)m_ * DM) + lane; \
            _Pragma("unroll") for (int j = 0; j < 4; ++j) mwv[rr][j] = mr[64 * j]; } } while (0)
        if (tl0 < tl1) P6_LOAD(tl0);
        for (int tl = tl0; tl < tl1; ++tl, nloc += 16) {
            {
#pragma unroll
                for (int rr = 0; rr < 2; ++rr) {
                    const int m = tl * 16 + 2 * wave + rr, b = m / SEQ;
                    if (b != bcur) { bcur = b;
#pragma unroll
                        for (int j = 0; j < 4; ++j) { sc2[j] = *(const f32x4*)(mod + b * NMOD + 4 * DM + 4 * lane + 256 * j); sh2[j] = *(const f32x4*)(mod + b * NMOD + 3 * DM + 4 * lane + 256 * j); } }
                    float ssum = 0.f;
#pragma unroll
                    for (int j = 0; j < 4; ++j) { const u32x2 w = mwv[rr][j];
                        v[rr][j][0] = __builtin_bit_cast(float, w.x << 16); v[rr][j][1] = __builtin_bit_cast(float, w.x & 0xffff0000u); v[rr][j][2] = __builtin_bit_cast(float, w.y << 16); v[rr][j][3] = __builtin_bit_cast(float, w.y & 0xffff0000u);
                        ssum += (v[rr][j][0] * v[rr][j][0] + v[rr][j][1] * v[rr][j][1]) + (v[rr][j][2] * v[rr][j][2] + v[rr][j][3] * v[rr][j][3]); }
                    const float rinv = rsqrtf(wave_sum(ssum) * (1.f / DM) + 1e-6f);
                    unsigned long long* o8 = (unsigned long long*)(H2 + (size_t)m * DM) + lane;
#pragma unroll
                    for (int j = 0; j < 4; ++j) { const int c0 = 4 * lane + 256 * j;
                        f32x4 o;
#pragma unroll
                        for (int q = 0; q < 4; ++q) o[q] = v[rr][j][q] * rinv * gv2[j][q] * (1.f + sc2[j][q]) + sh2[j][q];
                        o8[64 * j] = (unsigned long long)pk2(o[0], o[1]) | ((unsigned long long)pk2(o[2], o[3]) << 32);
                        *(LAS f32x4*)(hrow + (2 * wave + rr) * HP + c0) = o; }
                }
            }
            if (tl + 1 < tl1) P6_LOAD(tl + 1);
            __syncthreads();
            {
                f32x4 acc0 = (f32x4){0.f, 0.f, 0.f, 0.f}, acc1 = acc0;
                const LAS float* ap = hrow + li * HP + 128 * wave + lq;
#pragma unroll
                for (int sidx = 0; sidx < 32; ++sidx) { const float a = ap[4 * sidx];
                    acc0 = __builtin_amdgcn_mfma_f32_16x16x4f32(a, wreg[sidx][0], acc0, 0, 0, 0);
                    acc1 = __builtin_amdgcn_mfma_f32_16x16x4f32(a, wreg[sidx][1], acc1, 0, 0, 0); }
#pragma unroll
                for (int r = 0; r < 4; ++r) { red[(wave * 16 + 4 * lq + r) * 32 + li] = acc0[r]; red[(wave * 16 + 4 * lq + r) * 32 + 16 + li] = acc1[r]; }
            }
            __syncthreads();
            {
                const int rt = 2 * wave + (lane >> 5), m = tl * 16 + rt, lrow = nloc + rt;
                float lg = be;
#pragma unroll
                for (int k = 0; k < 8; ++k) lg += red[(k * 16 + rt) * 32 + e];
                int sel[4]; float sv[4];
#pragma unroll
                for (int k = 0; k < 4; ++k) {
                    float bv = lg; int bi = e;
#pragma unroll
                    for (int o = 16; o >= 1; o >>= 1) { const float ov = __shfl_xor(bv, o); const int oi = __shfl_xor(bi, o); if (ov > bv || (ov == bv && oi < bi)) { bv = ov; bi = oi; } }
                    sel[k] = bi; sv[k] = bv; if (e == bi) lg = -INFINITY;
                }
                if (e == 0) {
                    float w[4], ssum = 0.f;
#pragma unroll
                    for (int k = 0; k < 4; ++k) { w[k] = __expf(sv[k] - sv[0]); ssum += w[k]; }
                    const float rs = 1.f / ssum;
#pragma unroll
                    for (int k = 0; k < 4; ++k) { topi[m * 4 + k] = sel[k]; topw[m * 4 + k] = w[k] * rs;
                        if (lrow < 256) { lsel[lrow * 4 + k] = sel[k]; lwt[lrow * 4 + k] = w[k] * rs; lpos[lrow * 4 + k] = __hip_atomic_fetch_add(lcnt + sel[k], 1, __ATOMIC_RELAXED, __HIP_MEMORY_SCOPE_WORKGROUP); }
                        else { const int gp = (int)atomicAdd(ecnt + sel[k], 1u); tpos[m * 4 + k] = gp; list[(size_t)sel[k] * MTOK + gp] = m; lw[(size_t)sel[k] * MTOK + gp] = w[k] * rs; } }
                }
            }
        }
        __syncthreads();
        if (tid < 32) gbs[tid] = (int)atomicAdd(ecnt + tid, (unsigned)lcnt[tid]);
        __syncthreads();
        { const int nl = nloc < 256 ? nloc : 256;
          for (int sl = tid; sl < nl * 4; sl += NWAVES * 64) { const int lr = sl >> 2, k = sl & 3; const int mm = (tl0 + (lr >> 4)) * 16 + (lr & 15);
              const int ex = lsel[sl], gp = gbs[ex] + lpos[sl]; tpos[mm * 4 + k] = gp; list[(size_t)ex * MTOK + gp] = mm; lw[(size_t)ex * MTOK + gp] = lwt[sl]; } }
        __syncthreads();
    }
    SEAM(6);
    LAS int* texp = (LAS int*)(lds + LDS_TEXP);
    if (IN(8) || IN(9) || IN(10)) {
        if (tid == 0) { int t = 0; for (int ex = 0; ex < NEXP; ++ex) { const int c = (int)ecnt[ex]; texp[600 + ex] = c; const int nt = (c + 255) >> 8; texp[544 + ex] = t; for (int q = 0; q < nt; ++q) texp[t + q] = ex; t += nt; } texp[544 + NEXP] = t; }
        __syncthreads();
    }
    bf16_t* ACT = (bf16_t*)(ws + F_ACT);
    if (IN(8)) {
        const int T = texp[544 + NEXP];
        pg8::Gemm g{H2, WguT, DM, DM}; pg8::GroupOrder S; S.so.init(T * 256, 2 * DFF, G, bx, REPS(8)); S.texp = texp;
        pg8::EpiSwiglu E{ACT, b_gu, texp};
        pg8::GatherInfo gi{(const int*)(ws + F_LIST), texp + 600, (LAS int*)(lds + LDS_IDX)};
        pg8::gemm_phase<pg8::EpiSwiglu, pg8::GroupOrder, true, true, true>(lds, g, S, E, gi);
    }
    SEAM(8);
    bf16_t* Y = (bf16_t*)(ws + F_Y);
    if (IN(9)) {
        const int T = texp[544 + NEXP];
        pg8::Gemm g{ACT, WdT, DFF, DFF}; pg8::GroupOrder S; S.so.init(T * 256, DM, G, bx, REPS(9)); S.texp = texp;
        pg8::EpiDown E{Y, b_dn, (const float*)(ws + F_LW), texp};
        pg8::gemm_phase<pg8::EpiDown, pg8::GroupOrder, true, true>(lds, g, S, E);
    }
    SEAM(9);
    for (int rep = 0; rep < (REPS(11) - 1) * 10; ++rep) xcd_barrier(bar);
    if (IN(10)) {
        for (int rep = 0; rep < REPS(10); ++rep) {
        const int rpw = (MTOK + NGW - 1) / NGW, m0 = gw * rpw, m1 = (m0 + rpw < MTOK) ? m0 + rpw : MTOK;
        f32x4 gf[4], gt[4]; int bcur = -1;
#pragma unroll
        for (int j = 0; j < 4; ++j) gf[j] = *(const f32x4*)(g_fin + 4 * lane + 256 * j);
        for (int m = m0; m < m1; m += 2) {
            const bool two = (m + 1 < m1);
            f32x4 v[2][4];
            u32x2 yw[2][4][4]; u32x2 mw[2][4];
#pragma unroll
            for (int rr = 0; rr < 2; ++rr) {
                const int mm = (rr && !two) ? m : m + rr;
                const u32x2* mr = (const u32x2*)(MIXG + (size_t)mm * DM) + lane;
                int rows[4];
#pragma unroll
                for (int k = 0; k < 4; ++k) rows[k] = texp[544 + topi[mm * 4 + k]] * 256 + tpos[mm * 4 + k];
#pragma unroll
                for (int j = 0; j < 4; ++j) { mw[rr][j] = mr[64 * j];
#pragma unroll
                    for (int k = 0; k < 4; ++k) yw[rr][j][k] = *(const u32x2*)(Y + (size_t)rows[k] * DM + 4 * lane + 256 * j); }
            }
#pragma unroll
            for (int rr = 0; rr < 2; ++rr) {
                if (rr == 1 && !two) break;
                const int mm = m + rr, b = mm / SEQ;
                if (b != bcur) { bcur = b;
#pragma unroll
                    for (int j = 0; j < 4; ++j) gt[j] = *(const f32x4*)(mod + b * NMOD + 5 * DM + 4 * lane + 256 * j); }
                float ssum = 0.f;
#pragma unroll
                for (int j = 0; j < 4; ++j) {
                    f32x4 y = (f32x4){0.f, 0.f, 0.f, 0.f};
#pragma unroll
                    for (int k = 0; k < 4; ++k) { const u32x2 w = yw[rr][j][k];
                        y[0] += __builtin_bit_cast(float, w.x << 16); y[1] += __builtin_bit_cast(float, w.x & 0xffff0000u); y[2] += __builtin_bit_cast(float, w.y << 16); y[3] += __builtin_bit_cast(float, w.y & 0xffff0000u); }
                    const u32x2 w = mw[rr][j]; f32x4 mx; mx[0] = __builtin_bit_cast(float, w.x << 16); mx[1] = __builtin_bit_cast(float, w.x & 0xffff0000u); mx[2] = __builtin_bit_cast(float, w.y << 16); mx[3] = __builtin_bit_cast(float, w.y & 0xffff0000u);
                    v[rr][j] = mx + gt[j] * y;
                    ssum += (v[rr][j][0] * v[rr][j][0] + v[rr][j][1] * v[rr][j][1]) + (v[rr][j][2] * v[rr][j][2] + v[rr][j][3] * v[rr][j][3]);
                }
                const float rinv = rsqrtf(wave_sum(ssum) * (1.f / DM) + 1e-6f);
                f32x4* orow = (f32x4*)(args.out + (size_t)mm * DM) + lane;
#pragma unroll
                for (int j = 0; j < 4; ++j) orow[64 * j] = v[rr][j] * rinv * gf[j];
            }
        }
        }
    }
#undef P6_LOAD
#undef IN
#undef SEAM
}

static int mk_grid = 0;
static void launch_mk(void* const* d_in, void* d_out, void* d_ws, int lo, int hi, int li, hipStream_t stream) {
    if (mk_grid == 0) {
        int dev = 0, cus = 0;
        if (hipGetDevice(&dev) != hipSuccess || hipDeviceGetAttribute(&cus, hipDeviceAttributeMultiprocessorCount, dev) != hipSuccess) { mk_grid = -1; return; }
        if (hipFuncSetAttribute((const void*)mk_fwd, hipFuncAttributeMaxDynamicSharedMemorySize, LDS_BYTES) != hipSuccess) { fprintf(stderr, "hipFuncSetAttribute failed\n"); mk_grid = -1; return; }
        mk_grid = cus;
    }
    if (mk_grid < 0) return;
    MkArgs a{};
    for (int i = 0; i < 25; ++i) a.in[i] = (const float*)d_in[i];
    a.out = (float*)d_out; a.ws = (unsigned char*)d_ws; a.ph_lo_hi = (long long)lo | ((long long)hi << 16) | ((long long)li << 32);
    hipLaunchKernelGGL(mk_fwd, dim3(mk_grid), dim3(NWAVES * 64), LDS_BYTES, stream, a);
}
extern "C" void kernel_launch(void* const* d_in, const int* in_sizes, int n_in, void* d_out, int out_size, void* d_ws, size_t ws_size, hipStream_t stream) {
    if (n_in != 25 || out_size != MTOK * DM || ws_size < F_END) { fprintf(stderr, "kernel_launch: built for 25 inputs, %d outputs, >= %zu bytes of workspace; got n_in %d, out %d, ws %zu; nothing launched\n", MTOK * DM, (size_t)F_END, n_in, out_size, ws_size); return; }
    (void)in_sizes;
    (void)hipMemsetAsync((char*)d_ws + F_CTL, 0, 1 * MiB, stream);
    launch_mk(d_in, d_out, d_ws, 0, N_PHASES, 0, stream);
}
```

```cpp
#include <hip/hip_runtime.h>
#include <cstdio>
#include <cstdint>
constexpr int NB = 16, SEQ = 2048, DM = 1024, MTOK = NB * SEQ;
constexpr int QRANK = 384, KVRANK = 256, ROPE_D = 32, NOPE_D = 64, MLA_V = 64, MLA_QK = 96, MLA_H = 8;
constexpr int DIFF_H = 4, DIFF_D = 64;
constexpr int INCOLS = 2208;
constexpr int C_CQ = 0, C_CKV = 384, C_KPE = 640, C_DQ = 672, C_DK = 1184, C_DV = 1696;
constexpr int NEXP = 32, TOPK = 4, DFF = 1024;
constexpr int NMOD = 6 * DM;
constexpr float LAMBDA_INIT = 0.2f;

__constant__ float INVF16[16] = {1.000000000e+00f, 4.403665960e-01f, 1.939227432e-01f, 8.539710194e-02f, 3.760603070e-02f, 1.656044088e-02f, 7.292664610e-03f, 3.211446106e-03f,
                                 1.414213562e-03f, 6.227724371e-04f, 2.742481884e-04f, 1.207697351e-04f, 5.318295734e-05f, 2.341999971e-05f, 1.031338525e-05f, 4.541670478e-06f};
__constant__ float INVF8[8] = {1.000000000e+00f, 1.939227432e-01f, 3.760603070e-02f, 7.292664610e-03f, 1.414213562e-03f, 2.742481884e-04f, 5.318295734e-05f, 1.031338525e-05f};

constexpr size_t MiB = 1u << 20;

template <int CTRL> __device__ __forceinline__ float dppf(float v) { return __builtin_bit_cast(float, __builtin_amdgcn_update_dpp(0, __builtin_bit_cast(int, v), CTRL, 0xF, 0xF, true)); }
template <int CTRL> __device__ __forceinline__ int dppi(int v) { return __builtin_amdgcn_update_dpp(0, v, CTRL, 0xF, 0xF, true); }
constexpr int DPP_X1 = 0xB1, DPP_X2 = 0x4E, DPP_HM = 0x141, DPP_RM = 0x140;
__device__ __forceinline__ float wave_sum(float v) {
    v += dppf<DPP_X1>(v); v += dppf<DPP_X2>(v); v += dppf<DPP_HM>(v); v += dppf<DPP_RM>(v);
    { const auto r = __builtin_amdgcn_permlane16_swap(__float_as_uint(v), __float_as_uint(v), false, false); v = __uint_as_float(r[0]) + __uint_as_float(r[1]); }
    { const auto r = __builtin_amdgcn_permlane32_swap(__float_as_uint(v), __float_as_uint(v), false, false); v = __uint_as_float(r[0]) + __uint_as_float(r[1]); }
    return v;
}

#ifndef PROBE_REP
#define PROBE_REP 0
#endif
#define LAS __attribute__((address_space(3)))
#define GAS __attribute__((address_space(1)))
typedef unsigned short bf16_t;
typedef short bf16x8 __attribute__((ext_vector_type(8)));
typedef float f32x4 __attribute__((ext_vector_type(4)));
typedef float f32x2 __attribute__((ext_vector_type(2)));
typedef float f32x16 __attribute__((ext_vector_type(16)));
typedef unsigned u32x4 __attribute__((ext_vector_type(4)));
typedef unsigned u32x2 __attribute__((ext_vector_type(2)));

constexpr size_t F_CTL = 0;
constexpr size_t F_MOD = 512 * 1024;
constexpr size_t F_MISC = 1 * MiB;
constexpr size_t F_ROPE = 2 * MiB;
constexpr size_t F_SSQP = 8 * MiB;
constexpr size_t F_TOPI = 11 * MiB;
constexpr size_t F_TOPW = 11 * MiB + 512 * 1024;
constexpr size_t F_TPOS = 12 * MiB;
constexpr size_t F_LIST = 890 * MiB;
constexpr size_t F_LW = 894 * MiB;
constexpr size_t F_WIN = 16 * MiB;
constexpr size_t F_WUQ = 21 * MiB;
constexpr size_t F_WUKV = 22 * MiB;
constexpr size_t F_WOUT = 23 * MiB;
constexpr size_t F_WGU = 26 * MiB;
constexpr size_t F_WD = 154 * MiB;
constexpr size_t F_X1 = 218 * MiB;
constexpr size_t F_R1 = 346 * MiB;
constexpr size_t F_H1 = F_R1, F_ATT = F_R1 + 64 * MiB, F_HS = F_R1, F_Y = F_R1;
constexpr size_t F_R2 = 618 * MiB;
constexpr size_t F_PROJ = F_R2, F_QMLA = F_R2 + 144 * MiB, F_KV = F_QMLA + 48 * MiB, F_H2 = F_R1, F_ACT = F_R2;
constexpr size_t F_O1S = 898 * MiB;
constexpr size_t F_MODP = 914 * MiB;
constexpr size_t F_END = 921 * MiB;
constexpr int PROJ_LD = 2304;
constexpr int P_CQ = 0, P_CKV = 384, P_DQ = 640, P_DK = 1152, P_DV = 1664, P_KPE = 2176;
constexpr int SROWS_MAX = 139264;
constexpr float C2_MLA = 0.10206207261596575f * 1.4426950408889634f, C2_DIFF = 0.125f * 1.4426950408889634f;
constexpr int CW_BAR = 4096;
constexpr int CW_CNT = 2048;
constexpr int CW_MODD = 1280;
constexpr int CW_MODC = 1024;

__device__ __forceinline__ unsigned f2bf(float f) { unsigned u = __builtin_bit_cast(unsigned, f); return (u + 0x7fffu + ((u >> 16) & 1u)) >> 16; }
__device__ __forceinline__ unsigned pk2(float lo, float hi) { return f2bf(lo) | (f2bf(hi) << 16); }
__device__ __forceinline__ float bf2f(unsigned short h) { return __builtin_bit_cast(float, (unsigned)h << 16); }
__device__ __forceinline__ unsigned pk4_fp8(float a, float b, float c, float d) { int w = 0; w = __builtin_amdgcn_cvt_pk_fp8_f32(a, b, w, false); w = __builtin_amdgcn_cvt_pk_fp8_f32(c, d, w, true); return (unsigned)w; }
constexpr float Y8_SCALE = 8.f;
constexpr float W8_SCALE = 64.f;
__device__ __forceinline__ unsigned cvt_pk_bf16(float lo, float hi) { unsigned r; asm volatile("v_cvt_pk_bf16_f32 %0, %1, %2" : "=v"(r) : "v"(lo), "v"(hi)); return r; }

__device__ __forceinline__ int lane_id() { int l; asm volatile("v_mbcnt_lo_u32_b32 %0, -1, 0\n\tv_mbcnt_hi_u32_b32 %0, -1, %0" : "=v"(l)); return l; }
#define XB_TMO      128
#define XB_XCNT(j)  (256  + 64 * (j))
#define XB_XSUB(j)  (1280 + 64 * (j))
#define XB_XGEN(j)  (2304 + 64 * (j))
#define XB_TOP      3328
#define XB_TOPGEN   3392
#define XCD_BAR_WORDS 3456
#define XB_SPIN_CAP (1u << 20)
__device__ __forceinline__ unsigned xb_ld(unsigned* p)              { return __hip_atomic_load(p, __ATOMIC_RELAXED, __HIP_MEMORY_SCOPE_AGENT); }
__device__ __forceinline__ unsigned xb_add(unsigned* p, unsigned v) { return __hip_atomic_fetch_add(p, v, __ATOMIC_RELAXED, __HIP_MEMORY_SCOPE_AGENT); }
__device__ __forceinline__ unsigned xb_xcc_id() { return (unsigned)__builtin_amdgcn_s_getreg((3 << 11) | 20) & 0xFu; }
#define XB_SPIN(cond, bar) do { unsigned _sp = 0; while (cond) { __builtin_amdgcn_s_sleep(1); \
    if ((++_sp & 255u) == 0u) { if (xb_ld(&(bar)[XB_TMO])) break; if (_sp > XB_SPIN_CAP) { atomicAdd(&(bar)[XB_TMO], 1u); break; } } } } while (0)
struct XcdBarrier { unsigned* bar; unsigned x; volatile LAS unsigned* st; bool w0; };
__device__ __forceinline__ XcdBarrier xcd_barrier_post(unsigned* bar, volatile LAS unsigned* st) {
    XcdBarrier b; b.bar = bar; b.x = xb_xcc_id(); b.st = st; b.w0 = __builtin_amdgcn_readfirstlane((int)(threadIdx.x >> 6)) == 0;
    if (threadIdx.x == 0) (void)xb_add(&bar[XB_XCNT(b.x)], 1u);
    return b;
}
__device__ __forceinline__ void xcd_barrier_complete(unsigned* bar, unsigned x, unsigned& nloc, unsigned& nx) {
    const unsigned G = gridDim.x * gridDim.y * gridDim.z;
    unsigned sum, cnt, mine, sp = 0u;
    for (;;) {
        sum = 0u; cnt = 0u; mine = 0u;
#pragma unroll
        for (unsigned j = 0; j < 16; ++j) { const unsigned c = xb_ld(&bar[XB_XCNT(j)]); sum += c; cnt += (c > 0u) ? 1u : 0u; mine = (j == x) ? c : mine; }
        if (sum == G) break;
        __builtin_amdgcn_s_sleep(1);
        if ((++sp & 255u) == 0u) { if (xb_ld(&bar[XB_TMO])) break; if (sp > XB_SPIN_CAP) { atomicAdd(&bar[XB_TMO], 1u); break; } }
    }
    nloc = mine > 0u ? mine : 1u; nx = cnt > 0u ? cnt : 1u;
}
__device__ __forceinline__ void xcd_barrier(const XcdBarrier& b) {
    asm volatile("s_waitcnt vmcnt(0)" ::: "memory");
    __syncthreads();
    if (b.w0 && lane_id() == 0) {
        unsigned* bar = b.bar;
        __builtin_amdgcn_s_waitcnt(0);
        unsigned nloc = b.st[0], nx = b.st[1];
        if (nloc == 0u) { xcd_barrier_complete(bar, b.x, nloc, nx); b.st[0] = nloc; b.st[1] = nx; }
        const unsigned old = xb_add(&bar[XB_XSUB(b.x)], 1u);
        const unsigned gen = old / nloc;
        if (old + 1u == (gen + 1u) * nloc) {
            __builtin_amdgcn_fence(__ATOMIC_RELEASE, "agent");
            asm volatile("s_waitcnt vmcnt(0)" ::: "memory");
            const unsigned og = xb_add(&bar[XB_TOP], 1u);
            const unsigned tg = og / nx;
            if (og + 1u == (tg + 1u) * nx) xb_add(&bar[XB_TOPGEN], 1u);
            else XB_SPIN(xb_ld(&bar[XB_TOPGEN]) == tg, bar);
            __builtin_amdgcn_fence(__ATOMIC_ACQUIRE, "agent");
            xb_add(&bar[XB_XGEN(b.x)], 1u);
            asm volatile("s_waitcnt vmcnt(0)" ::: "memory");
        } else {
            XB_SPIN(xb_ld(&bar[XB_XGEN(b.x)]) == gen, bar);
            __builtin_amdgcn_fence(__ATOMIC_ACQUIRE, "agent");
            asm volatile("s_waitcnt vmcnt(0)" ::: "memory");
        }
    }
    __syncthreads();
}

namespace pg8 {
constexpr int PF_OFF = 131072;
constexpr int BM = 256, BK = 64, HALF = 128, HTB = HALF * BK * 2, STAGE_BYTES = 8 * HTB, NXCD = 8, WGM = 8;
__host__ __device__ __forceinline__ int lds_byte(int r, int c) { const int st = (r >> 4) * 2 + (c >> 5), rr = r & 15, cc = c & 31, ob = rr * 64 + cc * 2; return st * 1024 + (ob ^ (((ob >> 9) & 1) << 5)); }
__host__ __device__ __forceinline__ void stage_rc(int b, int& R, int& C) { const int st = b / 1024, sb = b % 1024, swz = sb ^ (((sb >> 9) & 1) << 5); R = (st >> 1) * 16 + swz / 64; C = (st & 1) * 32 + (swz % 64) / 2; }
__host__ __device__ __forceinline__ int perm32(int rho) { const int n = rho >> 4, i = rho & 15; return 8 * (i >> 2) + 4 * n + (i & 3); }
struct Unit { int pm, pn, pb, e, jl; };
struct Gemm { const bf16_t* A; const bf16_t* Bt; int lda, K; };
struct StaticOrder {
    int nM, nN, nwg, G, c, rep; unsigned mg;
    __device__ void init(int M, int N, int G_, int c_, int rep_ = 1) { nM = M / BM; nN = N / BM; nwg = nM * nN; G = G_; c = c_; rep = rep_; mg = 0xFFFFFFFFu / (unsigned)(WGM * nN) + 1u; }
    __device__ bool next(int i, Unit& u) const {
#if PROBE_REP
        long L = (long)i * G + c; if (L >= (long)nwg * rep) return false;
        L %= nwg;
        int wgid = (int)L;
#else
        int wgid = i * G + c; if (wgid >= nwg) return false;
#endif
        { const int q = nwg >> 3, r = nwg & 7, xcd = wgid & 7, off = wgid >> 3; wgid = (xcd < r ? xcd * (q + 1) : r * (q + 1) + (xcd - r) * q) + off; }
        const int nig = WGM * nN, gid = (int)(((unsigned long long)(unsigned)wgid * mg) >> 32), rem = wgid - gid * nig, fm = gid * WGM, gsz = (nM - fm) < WGM ? (nM - fm) : WGM;
        int qd, rm;
        if (gsz == WGM) { qd = rem >> 3; rm = rem & 7; }
        else { const int inv = gsz == 1 ? 65536 : gsz == 2 ? 32768 : gsz == 3 ? 21846 : gsz == 4 ? 16384 : gsz == 5 ? 13108 : gsz == 6 ? 10923 : 9363; qd = (rem * inv) >> 16; rm = rem - qd * gsz; }
#if PROBE_REP
        u.pm = fm + rm; u.pn = qd; u.pb = u.pn; u.e = 0; u.jl = ((long)i * G + c >= (long)nwg) ? 1 : 0; return true;
#else
        u.pm = fm + rm; u.pn = qd; u.pb = u.pn; u.e = 0; u.jl = 0; return true;
#endif
    }
};
struct GroupOrder {
    StaticOrder so; const LAS int* texp;
    __device__ bool next(int i, Unit& u) const { if (!so.next(i, u)) return false; u.e = __builtin_amdgcn_readfirstlane(texp[u.pm]); u.jl = u.pm - __builtin_amdgcn_readfirstlane(texp[544 + u.e]); u.pb = u.e * so.nN + u.pn; return true; }
};

struct GatherInfo { const int* list; const LAS int* cnt; LAS int* idx; };
typedef int i32x4 __attribute__((ext_vector_type(4))); typedef int i32x8 __attribute__((ext_vector_type(8)));
template <class Epi, class Sched, bool ALIGN_EPI = false, bool SP2 = false, bool GATHER = false, bool F8 = false>
__device__ __forceinline__ void gemm_phase(LAS unsigned char* lds, const int wid, const Gemm g, const Sched& S, const Epi& E, const GatherInfo gi = GatherInfo{nullptr, nullptr, nullptr}) {
    static_assert(SP2, "only the two-super-phase loop is kept");
    const int lane = lane_id(), tid = wid * 64 + lane, wr = wid >> 2, wc = wid & 3, fr = lane & 15, fq = lane >> 4;
    const int K = g.K, nt = K / BK, lda = g.lda;
    unsigned voffA2[2][2], voffB[2]; int gR[2], gC[2];
#pragma unroll
    for (int i = 0; i < 2; ++i) { int R, C; stage_rc(tid * 16 + i * 8192, R, C); const int Rb = Epi::PERM ? ((R & ~31) + perm32(R & 31)) : R;
        voffA2[0][i] = voffA2[1][i] = (unsigned)(R * lda + C) * 2u; voffB[i] = (unsigned)(Rb * K + C) * 2u; gR[i] = R; gC[i] = C; }
    const size_t kstep = (size_t)(BK * 2);
    const size_t hstepA = GATHER ? 0 : (size_t)HALF * lda * 2, hstepB = (size_t)HALF * K * 2;
    const size_t tstepA = 2 * hstepA, tstepB = 2 * hstepB;
    const unsigned ldsw = (unsigned)wid * 1024u;
    const int aoff = lds_byte(wr * 64 + fr, fq * 8), boff = lds_byte(wc * 32 + fr, fq * 8);
#define PG8_SA(b, h) (((b) * 2 + (h)) * HTB)
#define PG8_SB(b, h) ((4 + (b) * 2 + (h)) * HTB)
#define PG8_STAGE(bufoff, gbase, voff) do { _Pragma("unroll") for (int _i = 0; _i < 2; ++_i) \
        __builtin_amdgcn_global_load_lds((const unsigned*)((const char*)(gbase) + (voff)[_i]), (LAS unsigned*)(lds + (bufoff) + ldsw + _i * 8192), 16, 0, 0); } while (0)
#define PG8_LDA(dst, b, h) do { if constexpr (F8) { _Pragma("unroll") for (int m = 0; m < 4; ++m) { const i32x4 lo_ = *(const LAS i32x4*)(lds + PG8_SA(b, h) + aoff + m * 2048), hi_ = *(const LAS i32x4*)(lds + PG8_SA(b, h) + aoff + m * 2048 + 1024); \
            dst.f8[m] = __builtin_shufflevector(lo_, hi_, 0, 1, 2, 3, 4, 5, 6, 7); } } \
        else { _Pragma("unroll") for (int m = 0; m < 4; ++m) _Pragma("unroll") for (int k = 0; k < 2; ++k) dst.b16[m][k] = *(const LAS bf16x8*)(lds + PG8_SA(b, h) + aoff + m * 2048 + k * 1024); } } while (0)
#define PG8_LDB(dst, b, h) do { if constexpr (F8) { _Pragma("unroll") for (int n = 0; n < 2; ++n) { const i32x4 lo_ = *(const LAS i32x4*)(lds + PG8_SB(b, h) + boff + n * 2048), hi_ = *(const LAS i32x4*)(lds + PG8_SB(b, h) + boff + n * 2048 + 1024); \
            dst.f8[n] = __builtin_shufflevector(lo_, hi_, 0, 1, 2, 3, 4, 5, 6, 7); } } \
        else { _Pragma("unroll") for (int n = 0; n < 2; ++n) _Pragma("unroll") for (int k = 0; k < 2; ++k) dst.b16[n][k] = *(const LAS bf16x8*)(lds + PG8_SB(b, h) + boff + n * 2048 + k * 1024); } } while (0)
#define PG8_MMA(ai, bj, At, Bt) do { __builtin_amdgcn_s_setprio(1); \
        if constexpr (F8) { _Pragma("unroll") for (int m = 0; m < 4; ++m) _Pragma("unroll") for (int n = 0; n < 2; ++n) \
            acc[ai][bj][m][n] = __builtin_amdgcn_mfma_scale_f32_16x16x128_f8f6f4(Bt.f8[n], At.f8[m], acc[ai][bj][m][n], 0, 0, 0, 0, 0, 0); } \
        else { _Pragma("unroll") for (int m = 0; m < 4; ++m) _Pragma("unroll") for (int n = 0; n < 2; ++n) _Pragma("unroll") for (int k = 0; k < 2; ++k) \
            acc[ai][bj][m][n] = __builtin_amdgcn_mfma_f32_16x16x32_bf16(Bt.b16[n][k], At.b16[m][k], acc[ai][bj][m][n], 0, 0, 0); } \
        __builtin_amdgcn_s_setprio(0); } while (0)
#define PG8_WAIT_V(n) asm volatile("s_waitcnt vmcnt(" #n ")" ::: "memory")
#define PG8_WAIT_L(n) asm volatile("s_waitcnt lgkmcnt(" #n ")" ::: "memory")
#define PG8_BAR __builtin_amdgcn_s_barrier()
#define PG8_SCHED __builtin_amdgcn_sched_barrier(0)
#define PG8_GFETCH(U) do { if (wid == 0) __builtin_amdgcn_global_load_lds((const unsigned*)(gi.list + (size_t)(U).e * MTOK + (U).jl * 256 + lane * 4), (LAS unsigned*)gi.idx, 16, 0, 0); } while (0)
#define PG8_GOFFS(U) do { const int _cn = gi.cnt[(U).e] - (U).jl * 256; _Pragma("unroll") for (int _h = 0; _h < 2; ++_h) _Pragma("unroll") for (int _i = 0; _i < 2; ++_i) { \
        const int _r = _h * HALF + gR[_i]; int _t = gi.idx[_r]; _t = (_r < _cn) ? _t : 0; voffA2[_h][_i] = ((unsigned)_t * (unsigned)lda + (unsigned)gC[_i]) * 2u; } } while (0)
    Unit cur, nxt; int ui = 0;
    if (!S.next(0, cur)) return;
    f32x4 acc[2][2][4][2];
#pragma unroll
    for (int a = 0; a < 2; ++a)
#pragma unroll
        for (int b = 0; b < 2; ++b)
#pragma unroll
            for (int m = 0; m < 4; ++m)
#pragma unroll
                for (int n = 0; n < 2; ++n) acc[a][b][m][n] = (f32x4){0.f, 0.f, 0.f, 0.f};
    struct { bf16x8 b16[4][2]; i32x8 f8[4]; } At; struct FragB_ { bf16x8 b16[2][2]; i32x8 f8[2]; }; FragB_ B0, B1;
    if constexpr (GATHER) { PG8_GFETCH(cur); PG8_WAIT_V(0); PG8_BAR; PG8_GOFFS(cur); PG8_WAIT_L(0); PG8_BAR; }
#define PG8_PF(U, SLOT) do { if constexpr (Epi::NPF > 0) { if (wid == 1) { _Pragma("unroll") for (int _p = 0; _p < Epi::NPF; ++_p) \
        __builtin_amdgcn_global_load_lds((const unsigned*)(E.pf_src((U), _p) + lane_id() * 4), (LAS unsigned*)(lds + PF_OFF + (SLOT) * 2048 + _p * 1024), 16, 0, 0); } } } while (0)
    const char* cA = (const char*)g.A + (size_t)cur.pm * tstepA; const char* cB = (const char*)g.Bt + (size_t)cur.pb * tstepB;
    {
        PG8_STAGE(PG8_SB(0, 0), cB, voffB); PG8_STAGE(PG8_SB(0, 1), cB + hstepB, voffB); PG8_STAGE(PG8_SA(0, 0), cA, voffA2[0]); PG8_STAGE(PG8_SA(0, 1), cA + hstepA, voffA2[1]);
        if (wr == 1) PG8_BAR;
        PG8_WAIT_V(2); PG8_BAR;
        PG8_STAGE(PG8_SB(1, 0), cB + kstep, voffB); PG8_STAGE(PG8_SA(1, 0), cA + kstep, voffA2[0]); PG8_STAGE(PG8_SB(1, 1), cB + hstepB + kstep, voffB);
        PG8_WAIT_V(6); PG8_BAR;
    }
    PG8_PF(cur, 0);
    for (;;) {
        const bool has_next = S.next(ui + 1, nxt);
        if constexpr (GATHER) { if (has_next) PG8_GFETCH(nxt); }
        const char* nA = has_next ? (const char*)g.A + (size_t)nxt.pm * tstepA : cA; const char* nB = has_next ? (const char*)g.Bt + (size_t)nxt.pb * tstepB : cB;
#pragma unroll 1
        for (int t = 0; t < nt; t += 2) {
            const bool last = (t == nt - 2);
            if constexpr (GATHER) asm volatile("" : "+v"(voffA2[0][0]), "+v"(voffA2[0][1]), "+v"(voffA2[1][0]), "+v"(voffA2[1][1]), "+v"(voffB[0]), "+v"(voffB[1]));
            else { asm volatile("" : "+v"(voffA2[0][0]), "+v"(voffA2[0][1]), "+v"(voffB[0]), "+v"(voffB[1])); voffA2[1][0] = voffA2[0][0]; voffA2[1][1] = voffA2[0][1]; }
            const char* a1 = cA + (size_t)(t + 1) * kstep;
            const char* a2 = last ? nA : cA + (size_t)(t + 2) * kstep; const char* b2 = last ? nB : cB + (size_t)(t + 2) * kstep;
            const char* a3 = a2 + kstep; const char* b3 = b2 + kstep;
            PG8_LDB(B0, 0, 0); PG8_LDB(B1, 0, 1); PG8_SCHED; PG8_LDA(At, 0, 0); PG8_STAGE(PG8_SA(1, 1), a1 + hstepA, voffA2[1]);
            if constexpr (GATHER) { if (last && has_next) PG8_GOFFS(nxt); }
            PG8_WAIT_V(8); PG8_WAIT_L(0); PG8_BAR; if (t == 0 && has_next) PG8_PF(nxt, (ui + 1) & 1);     PG8_MMA(0, 0, At, B0); PG8_MMA(0, 1, At, B1); PG8_BAR; PG8_SCHED;
            PG8_LDA(At, 0, 1); PG8_STAGE(PG8_SB(0, 0), b2, voffB); PG8_STAGE(PG8_SB(0, 1), b2 + hstepB, voffB); PG8_STAGE(PG8_SA(0, 0), a2, voffA2[0]);
            PG8_WAIT_V(8); PG8_WAIT_L(0); PG8_BAR; PG8_MMA(1, 0, At, B0); PG8_MMA(1, 1, At, B1); PG8_BAR; PG8_SCHED;
            PG8_LDB(B0, 1, 0); PG8_LDB(B1, 1, 1); PG8_SCHED; PG8_LDA(At, 1, 0); PG8_STAGE(PG8_SA(0, 1), a2 + hstepA, voffA2[1]);
            PG8_WAIT_V(8); PG8_WAIT_L(0); PG8_BAR; PG8_MMA(0, 0, At, B0); PG8_MMA(0, 1, At, B1); PG8_BAR; PG8_SCHED;
            PG8_LDA(At, 1, 1); PG8_STAGE(PG8_SB(1, 0), b3, voffB); PG8_STAGE(PG8_SB(1, 1), b3 + hstepB, voffB); PG8_STAGE(PG8_SA(1, 0), a3, voffA2[0]);
            PG8_WAIT_V(8); PG8_WAIT_L(0); PG8_BAR; PG8_MMA(1, 0, At, B0); PG8_MMA(1, 1, At, B1); PG8_BAR; PG8_SCHED;
        }
        if constexpr (ALIGN_EPI) { if (wr == 0) PG8_BAR; }
        { const int ln_ = lane_id();
          E(acc, cur, wr, wc, ln_ & 15, ln_ >> 4, (const LAS float*)(lds + PF_OFF + (ui & 1) * 2048)); }
        if (!has_next) break;
        {
            typedef _Float16 f16x4_ __attribute__((ext_vector_type(4)));
            f16x4_ zh = {(_Float16)0.f, (_Float16)0.f, (_Float16)0.f, (_Float16)0.f}; asm volatile("" : "+v"(zh));
#pragma unroll
            for (int a = 0; a < 2; ++a)
#pragma unroll
                for (int b = 0; b < 2; ++b)
#pragma unroll
                    for (int m = 0; m < 4; ++m)
#pragma unroll
                        for (int n = 0; n < 2; ++n) { asm volatile("" : "+v"(zh)); acc[a][b][m][n] = __builtin_amdgcn_mfma_f32_4x4x4f16(zh, zh, (f32x4){0.f, 0.f, 0.f, 0.f}, 0, 0, 0); }
        }
        cur = nxt; cA = nA; cB = nB; ++ui;
        if constexpr (ALIGN_EPI) { if (wr == 1) PG8_BAR; }
    }
    PG8_WAIT_V(0);
    if constexpr (!ALIGN_EPI) { if (wr == 0) PG8_BAR; }
    PG8_BAR;
#undef PG8_SA
#undef PG8_SB
#undef PG8_STAGE
#undef PG8_LDA
#undef PG8_LDB
#undef PG8_MMA
#undef PG8_WAIT_V
#undef PG8_WAIT_L
#undef PG8_BAR
#undef PG8_SCHED
#undef PG8_GFETCH
#undef PG8_GOFFS
#undef PG8_PF
}
typedef f32x4 AccT[2][2][4][2];
__device__ __forceinline__ float shx(float v, int ln, int m) { return __builtin_bit_cast(float, __builtin_amdgcn_ds_bpermute((ln ^ m) << 2, __builtin_bit_cast(int, v))); }

struct EpiProj {
    static constexpr bool PERM = true; static constexpr int NPF = 0;
    bf16_t* O; const float* rope; float* ssqp;
    __device__ __forceinline__ void operator()(const AccT& acc, const Unit& u, int wr, int wc, int fr, int fq, const LAS float* pf) const {
        const int G0 = u.pn * 8 + wc, G1 = G0 + 4;
        const bool any8 = (G0 >= 20 && G0 < 52 && ((G0 - 20) & 1) == 0) || (G1 >= 20 && G1 < 52 && ((G1 - 20) & 1) == 0), need = any8 || G0 == 68 || G1 == 68;
        f32x4 cs[2][2][4];
#define EP_LD(AM, BUF) do { _Pragma("unroll") for (int mm_ = 0; mm_ < 2; ++mm_) { const int row_ = u.pm * BM + ((AM) >> 1) * HALF + wr * 64 + (2 * ((AM) & 1) + mm_) * 16 + fr; \
            const float* T_ = rope + ((size_t)row_ * 24 + (any8 ? 16 : 8 * (fq & 1))) * 2; \
            _Pragma("unroll") for (int j4_ = 0; j4_ < 4; ++j4_) cs[BUF][mm_][j4_] = *(const f32x4*)(T_ + 4 * j4_); } } while (0)
        if (need) EP_LD(0, 0);
#pragma unroll
        for (int am = 0; am < 4; ++am) {
            const int ai = am >> 1;
            if (need && am < 3) EP_LD(am + 1, (am + 1) & 1);
#pragma unroll
            for (int bj = 0; bj < 2; ++bj) {
                const int G = u.pn * 8 + bj * 4 + wc;
                if (G > 68) continue;
                const bool is_sq = G < 20;
                const bool is_dq = (G >= 20 && G < 36), is_dk = (G >= 36 && G < 52), is_pe = (G == 68);
                const bool rope8 = (is_dq || is_dk) && (((G - 20) & 1) == 0);
#pragma unroll
                for (int mm = 0; mm < 2; ++mm) {
                    const int m = 2 * (am & 1) + mm;
                    const int row = u.pm * BM + ai * HALF + wr * 64 + m * 16 + fr;
                    float v[8];
#pragma unroll
                    for (int j = 0; j < 4; ++j) { v[j] = acc[ai][bj][m][0][j] * (1.f / W8_SCALE); v[4 + j] = acc[ai][bj][m][1][j] * (1.f / W8_SCALE); }
                    if (is_sq) {
                        float s = 0.f;
#pragma unroll
                        for (int j = 0; j < 8; ++j) s += v[j] * v[j];
                        s += shx(s, fq * 16 + fr, 16); s += shx(s, fq * 16 + fr, 32);
                        if (fq == 0) ssqp[(size_t)row * 20 + G] = s;
                    } else if (rope8) {
                        const float sgn = (fq == 0) ? -1.f : 1.f;
#pragma unroll
                        for (int j4 = 0; j4 < 4; ++j4)
#pragma unroll
                            for (int jj = 0; jj < 2; ++jj) { const int j = 2 * j4 + jj; const float pr = shx(v[j], fq * 16 + fr, 16); const float c = cs[am & 1][mm][j4][2 * jj], s = cs[am & 1][mm][j4][2 * jj + 1];
                                const float o = v[j] * c + sgn * pr * s; v[j] = (fq < 2) ? o : v[j]; }
                    } else if (is_pe) {
                        const float sgn = (fq < 2) ? -1.f : 1.f;
#pragma unroll
                        for (int j4 = 0; j4 < 4; ++j4)
#pragma unroll
                            for (int jj = 0; jj < 2; ++jj) { const int j = 2 * j4 + jj; const float pr = shx(v[j], fq * 16 + fr, 32); const float c = cs[am & 1][mm][j4][2 * jj], s = cs[am & 1][mm][j4][2 * jj + 1];
                                v[j] = v[j] * c + sgn * pr * s; }
                    }
                    const float sc = is_dq ? C2_DIFF : 1.f;
                    u32x4 w; w.x = cvt_pk_bf16(v[0] * sc, v[1] * sc); w.y = cvt_pk_bf16(v[2] * sc, v[3] * sc); w.z = cvt_pk_bf16(v[4] * sc, v[5] * sc); w.w = cvt_pk_bf16(v[6] * sc, v[7] * sc);
                    if (!(((PROBE_REP >> 20) & 1) && u.jl)) *(u32x4*)(O + (size_t)row * PROJ_LD + G * 32 + 8 * fq) = w;
                }
            }
        }
#undef EP_LD
    }
};
template <bool ISQ> struct EpiUp {
    static constexpr bool PERM = true; static constexpr int NPF = 0;
    bf16_t* O; const float* rope; const float* ssqp;
    __device__ __forceinline__ void operator()(const AccT& acc, const Unit& u, int wr, int wc, int fr, int fq, const LAS float* pf) const {
        constexpr int LDO = ISQ ? 768 : 1024;
        const int rl = wr * 64 + fr;
        unsigned o_rp = ((unsigned)rl * 48u + 16u * (unsigned)(fq & 1)) * 4u, o_out = ((unsigned)rl * LDO + 8u * (unsigned)fq) * 2u;
        asm volatile("" : "+v"(o_rp), "+v"(o_out));
        LAS float* scl = (LAS float*)pf;
        {   const int t = (wr * 4 + wc) * 64 + fq * 16 + fr;
            if (t < 256) { const char* sp = (const char*)(ssqp + (size_t)(u.pm * BM + t) * 20 + (ISQ ? 0 : 12)); float s = 0.f;
#pragma unroll
                for (int q = 0; q < (ISQ ? 3 : 2); ++q) { const f32x4 tq = *(const f32x4*)(sp + 16 * q); s += (tq[0] + tq[1]) + (tq[2] + tq[3]); }
                scl[t] = rsqrtf(s * (ISQ ? (1.f / 384.f) : (1.f / 256.f)) + 1e-6f) * (ISQ ? C2_MLA : 1.f); }
            __syncthreads(); }
#pragma unroll
        for (int ai = 0; ai < 2; ++ai)
#pragma unroll
            for (int m = 0; m < 4; ++m) {
                const int rowu = u.pm * BM + ai * HALF + m * 16;
                const float sc = scl[ai * HALF + m * 16 + rl];
#pragma unroll
                for (int bj = 0; bj < 2; ++bj) {
                    const int G = u.pn * 8 + bj * 4 + wc;
                    const bool is_pe = ISQ && (G % 3 == 2);
                    float v[8];
#pragma unroll
                    for (int j = 0; j < 4; ++j) { v[j] = acc[ai][bj][m][0][j]; v[4 + j] = acc[ai][bj][m][1][j]; }
                    if (is_pe) {
                        const char* T = (const char*)(rope + (size_t)rowu * 48);
                        const float sgn = (fq < 2) ? -1.f : 1.f;
#pragma unroll
                        for (int j4 = 0; j4 < 4; ++j4) { const f32x4 cs = *(const f32x4*)(T + o_rp + 16 * j4);
#pragma unroll
                            for (int jj = 0; jj < 2; ++jj) { const int j = 2 * j4 + jj; const float pr = shx(v[j], fq * 16 + fr, 32); const float c = cs[2 * jj], sn = cs[2 * jj + 1];
                                v[j] = v[j] * c + sgn * pr * sn; } }
                    }
                    u32x4 w; w.x = cvt_pk_bf16(v[0] * sc, v[1] * sc); w.y = cvt_pk_bf16(v[2] * sc, v[3] * sc); w.z = cvt_pk_bf16(v[4] * sc, v[5] * sc); w.w = cvt_pk_bf16(v[6] * sc, v[7] * sc);
                    *(u32x4*)((char*)(O + (size_t)rowu * LDO + G * 32) + o_out) = w;
                }
            }
    }
};
struct EpiOut {
    static constexpr bool PERM = true; static constexpr int NPF = 0;
    const float* mod; bf16_t* X1; const float* x;
    __device__ __forceinline__ void operator()(const AccT& acc, const Unit& u, int wr, int wc, int fr, int fq, const LAS float* pf) const {
        unsigned off = ((unsigned)(wr * 64 + fr) * DM + (unsigned)(wc * 32 + 8 * fq)) * 2u;
        asm volatile("" : "+v"(off));
        const float* gt = mod + (u.pm >> 3) * NMOD + 2 * DM;
        f32x4 xs[2][4][2];
#define EO_LD(B_, BUF) do { const int cu_ = u.pn * BM + ((B_) >> 1) * HALF; _Pragma("unroll") for (int m_ = 0; m_ < 4; ++m_) { \
            const f32x4* xp_ = (const f32x4*)((const char*)(x + (size_t)(u.pm * BM + ((B_) & 1) * HALF + m_ * 16) * DM + cu_) + 2u * off); xs[BUF][m_][0] = xp_[0]; xs[BUF][m_][1] = xp_[1]; } } while (0)
        EO_LD(0, 0);
#pragma unroll
        for (int b = 0; b < 4; ++b) {
            const int bj = b >> 1, ai = b & 1;
            const int cu = u.pn * BM + bj * HALF;
            const f32x4* gp = (const f32x4*)(gt + cu + wc * 32 + 8 * fq);
            const f32x4 g0 = gp[0] * (1.f / W8_SCALE), g1 = gp[1] * (1.f / W8_SCALE);
            if (b < 3) EO_LD(b + 1, (b + 1) & 1);
#pragma unroll
            for (int m = 0; m < 4; ++m) {
                const f32x4 v0 = acc[ai][bj][m][0] * g0 + xs[b & 1][m][0], v1 = acc[ai][bj][m][1] * g1 + xs[b & 1][m][1];
                u32x4 w; w.x = cvt_pk_bf16(v0[0], v0[1]); w.y = cvt_pk_bf16(v0[2], v0[3]); w.z = cvt_pk_bf16(v1[0], v1[1]); w.w = cvt_pk_bf16(v1[2], v1[3]);
                *(u32x4*)((char*)(X1 + (size_t)(u.pm * BM + ai * HALF + m * 16) * DM + cu) + off) = w;
            }
        }
#undef EO_LD
    }
};
__device__ __forceinline__ float swiglu_fast(float gate, float up) {
    gate = fminf(gate, 7.f); up = fminf(fmaxf(up, -7.f), 7.f);
    return gate * __builtin_amdgcn_rcpf(1.f + __builtin_amdgcn_exp2f(-1.702f * 1.4426950408889634f * gate)) * (up + 1.f);
}
struct EpiSwiglu {
    static constexpr bool PERM = true; static constexpr int NPF = 1;
    bf16_t* ACT; const float* bgu; const LAS int* texp;
    __device__ __forceinline__ const float* pf_src(const Unit& u, int) const { return bgu + (size_t)u.e * 2 * DFF + 2 * (u.pn * 128); }
    __device__ __forceinline__ void operator()(const AccT& acc, const Unit& u, int wr, int wc, int fr, int fq, const LAS float* pf) const {
        const LAS f32x4* bp = (const LAS f32x4*)(pf + 2 * (wc * 32 + 8 * fq));
        const f32x4 b0 = bp[0], b1 = bp[1], b2 = bp[2], b3 = bp[3];
        const float bg[8] = {b0[0], b0[2], b1[0], b1[2], b2[0], b2[2], b3[0], b3[2]}, bu[8] = {b0[1], b0[3], b1[1], b1[3], b2[1], b2[3], b3[1], b3[3]};
        unsigned off = (unsigned)(wr * 64 + fr + 16 * (fq & 1)) * DFF + (unsigned)(wc * 32 + 8 * (fq & 2));
        asm volatile("" : "+v"(off));
        constexpr float IS = 1.f / W8_SCALE;
#pragma unroll
        for (int ai = 0; ai < 2; ++ai)
#pragma unroll
            for (int mp = 0; mp < 2; ++mp) {
                u32x2 w[2];
#pragma unroll
                for (int mm = 0; mm < 2; ++mm) { const int m = 2 * mp + mm;
                    float a[8];
#pragma unroll
                    for (int n = 0; n < 2; ++n)
#pragma unroll
                        for (int jp = 0; jp < 4; jp += 2) {
                            const int j = 4 * n + jp;
                            f32x2 g2 = (f32x2){acc[ai][0][m][n][jp], acc[ai][0][m][n][jp + 1]} * IS + (f32x2){bg[j], bg[j + 1]};
                            f32x2 u2 = (f32x2){acc[ai][1][m][n][jp], acc[ai][1][m][n][jp + 1]} * IS + (f32x2){bu[j] + 1.f, bu[j + 1] + 1.f};
                            g2.x = fminf(g2.x, 7.f); g2.y = fminf(g2.y, 7.f); u2.x = fminf(fmaxf(u2.x, -6.f), 8.f); u2.y = fminf(fmaxf(u2.y, -6.f), 8.f);
                            const f32x2 z2 = g2 * (-1.702f * 1.4426950408889634f);
                            f32x2 d2 = (f32x2){__builtin_amdgcn_exp2f(z2.x), __builtin_amdgcn_exp2f(z2.y)} + 1.f;
                            const f32x2 r2 = (f32x2){__builtin_amdgcn_rcpf(d2.x), __builtin_amdgcn_rcpf(d2.y)};
                            const f32x2 o2 = (g2 * r2) * u2;
                            a[j] = o2.x; a[j + 1] = o2.y;
                        }
                    w[mm].x = pk4_fp8(a[0], a[1], a[2], a[3]); w[mm].y = pk4_fp8(a[4], a[5], a[6], a[7]); }
                const auto rx = __builtin_amdgcn_permlane16_swap(w[0].x, w[1].x, false, false), ry = __builtin_amdgcn_permlane16_swap(w[0].y, w[1].y, false, false);
                const u32x4 o = {rx[0], ry[0], rx[1], ry[1]};
                *(u32x4*)((char*)ACT + (size_t)(u.pm * BM + ai * HALF + mp * 32) * DFF + u.pn * 128 + off) = o;
            }
    }
};
struct EpiDown {
    static constexpr bool PERM = true; static constexpr int NPF = 2;
    bf16_t* Y; const float* bd; const float* roww; const LAS int* texp;
    __device__ __forceinline__ const float* pf_src(const Unit& u, int p) const { return p == 0 ? bd + (size_t)u.e * DM + u.pn * BM : roww + (size_t)u.e * MTOK + u.jl * BM; }
    __device__ __forceinline__ void operator()(const AccT& acc, const Unit& u, int wr, int wc, int fr, int fq, const LAS float* pf) const {
        unsigned off = (unsigned)(wr * 64 + fr + 16 * (fq & 1)) * DM + (unsigned)(wc * 32 + 8 * (fq & 2)), offw = (unsigned)(wr * 64 + fr) * 4u;
        asm volatile("" : "+v"(off), "+v"(offw));
#pragma unroll
        for (int bj = 0; bj < 2; ++bj) {
            const int cu = u.pn * BM + bj * HALF;
            const LAS f32x4* bp = (const LAS f32x4*)(pf + bj * HALF + wc * 32 + 8 * fq);
            const f32x4 b0 = bp[0], b1 = bp[1];
#pragma unroll
            for (int ai = 0; ai < 2; ++ai)
#pragma unroll
                for (int mp = 0; mp < 2; ++mp) {
                    u32x2 w[2];
#pragma unroll
                    for (int mm = 0; mm < 2; ++mm) { const int m = 2 * mp + mm;
                        const float w8 = *(const LAS float*)((const LAS char*)(pf + 256 + ai * HALF + m * 16) + offw);
                        const f32x4 v0 = (acc[ai][bj][m][0] * (1.f / W8_SCALE) + b0) * (w8 * Y8_SCALE), v1 = (acc[ai][bj][m][1] * (1.f / W8_SCALE) + b1) * (w8 * Y8_SCALE);
                        w[mm].x = pk4_fp8(v0[0], v0[1], v0[2], v0[3]); w[mm].y = pk4_fp8(v1[0], v1[1], v1[2], v1[3]); }
                    const auto rx = __builtin_amdgcn_permlane16_swap(w[0].x, w[1].x, false, false), ry = __builtin_amdgcn_permlane16_swap(w[0].y, w[1].y, false, false);
                    const u32x4 o = {rx[0], ry[0], rx[1], ry[1]};
                    *(u32x4*)((char*)Y + (size_t)(u.pm * BM + ai * HALF + mp * 32) * DM + cu + off) = o;
                }
        }
    }
};
}

namespace att {
typedef short v4i16_t __attribute__((ext_vector_type(4)));
constexpr int NSLOT = 3, K_OFF = 0, KSLOT = 12288, V_OFF = NSLOT * KSLOT, VSLOT = 16384, WS_OFF = V_OFF + NSLOT * VSLOT;
constexpr int CONV_OFF = WS_OFF + 8 * 256, CONV_WAVE = 8192;
constexpr int NCHUNK_GU = NEXP * 16 * 128, NCHUNK_DN = NEXP * 16 * 64, NCHUNK = NCHUNK_GU + NCHUNK_DN;
constexpr int CONV_PERIOD = 3;
constexpr float THR = 8.f;
__device__ __forceinline__ int crow(int r, int hi) { return (r & 3) + 8 * (r >> 2) + 4 * hi; }
struct Src { const bf16_t* q; const bf16_t* k1; const bf16_t* k2; const bf16_t* v; int qp, k1p, k2p, vp; };
struct Ring { int s_cur, s_nxt, s_fill; bool pre; };

__device__ __forceinline__ void glds16(const void* gsrc, unsigned lds_dst) { unsigned keep;
    asm volatile("s_mov_b32 %0, m0\n\ts_mov_b32 m0, %2\n\ts_nop 0\n\tglobal_load_lds_dwordx4 %1, off\n\ts_mov_b32 m0, %0" : "=&s"(keep) : "v"(gsrc), "s"(lds_dst) : "memory"); }
template <int DQK, int DV>
__device__ __forceinline__ void issue_tile(LAS unsigned char* lds, int wid, int lane, const Src& S, int t, int slot) {
    constexpr int KCH = DQK / 8, NVP = (DV / 32) * 4, NP = KCH + NVP;
#pragma unroll
    for (int pi = 0; pi < (NP + 7) / 8; ++pi) {
        const int p = wid + 8 * pi;
        if (p < NP) {
            const bf16_t* src; LAS unsigned char* dst;
            if (p < KCH) {
                const int cg = p >> 2, rg = p & 3, row = lane >> 2, ch = (lane & 3) ^ (row >> 2);
                src = (cg < 2) ? S.k1 + (size_t)(t * 64 + rg * 16 + row) * S.k1p + (cg * 4 + ch) * 8 : S.k2 + (size_t)(t * 64 + rg * 16 + row) * S.k2p + ch * 8;
                dst = lds + K_OFF + slot * KSLOT + p * 1024;
            } else {
                const int v = p - KCH, dblk = v >> 2, rg = v & 3;
                src = S.v + (size_t)(t * 64 + 16 * rg + (lane >> 2)) * S.vp + dblk * 32 + (lane & 3) * 8;
                dst = lds + V_OFF + slot * VSLOT + v * 1024;
            }
            glds16(src, (unsigned)__builtin_amdgcn_readfirstlane((int)(unsigned)(uintptr_t)dst));
        }
    }
}
typedef float f32x2_t __attribute__((ext_vector_type(2))); typedef __bf16 bf16x2_t __attribute__((ext_vector_type(2)));
__device__ __forceinline__ unsigned cvtpk_s(float lo, float hi) { f32x2_t v = {lo, hi}; bf16x2_t b = __builtin_convertvector(v, bf16x2_t); return __builtin_bit_cast(unsigned, b); }
__device__ __forceinline__ float max3f(float a, float b, float c) { float r; asm("v_max3_f32 %0, %1, %2, %3" : "=v"(r) : "v"(a), "v"(b), "v"(c)); return r; }
__device__ __forceinline__ float max2f(float a, float b) { float r; asm("v_max_f32_e32 %0, %1, %2" : "=v"(r) : "v"(a), "v"(b)); return r; }
__device__ __forceinline__ float fadd_s(float a, float b) { float r; asm("v_add_f32_e32 %0, %1, %2" : "=v"(r) : "v"(a), "v"(b)); return r; }
template <int DQK>
__device__ __forceinline__ void qk_tile(const LAS unsigned char* Ks, const bf16x8* qr, const f32x16& negm, f32x16& p0, f32x16& p1) {
#pragma unroll
    for (int d0 = 0; d0 < DQK / 16; ++d0) {
        const bf16x8 kb0 = *(const LAS bf16x8*)(Ks + d0 * 2048), kb1 = *(const LAS bf16x8*)(Ks + d0 * 2048 + 512);
        if (d0 == 0) { p0 = __builtin_amdgcn_mfma_f32_32x32x16_bf16(kb0, qr[0], negm, 0, 0, 0); p1 = __builtin_amdgcn_mfma_f32_32x32x16_bf16(kb1, qr[0], negm, 0, 0, 0); }
        else { p0 = __builtin_amdgcn_mfma_f32_32x32x16_bf16(kb0, qr[d0], p0, 0, 0, 0); p1 = __builtin_amdgcn_mfma_f32_32x32x16_bf16(kb1, qr[d0], p1, 0, 0, 0); }
    }
}
template <int DQK>
__device__ __forceinline__ void k_load(const LAS unsigned char* Ks, int koff_e, int koff_o, bf16x8 (&kf)[DQK / 8]) {
#pragma unroll
    for (int d0 = 0; d0 < DQK / 16; ++d0) { const LAS unsigned char* p = Ks + (d0 >> 1) * 4096 + ((d0 & 1) ? koff_o : koff_e);
        kf[2 * d0] = *(const LAS bf16x8*)p; kf[2 * d0 + 1] = *(const LAS bf16x8*)(p + 2048); }
}
template <int DQK>
__device__ __forceinline__ void qk_regs(const bf16x8 (&kf)[DQK / 8], const bf16x8* qr, const f32x16& negm, f32x16& p0, f32x16& p1) {
#pragma unroll
    for (int d0 = 0; d0 < DQK / 16; ++d0) {
        if (d0 == 0) { p0 = __builtin_amdgcn_mfma_f32_32x32x16_bf16(kf[0], qr[0], negm, 0, 0, 0); p1 = __builtin_amdgcn_mfma_f32_32x32x16_bf16(kf[1], qr[0], negm, 0, 0, 0); }
        else { p0 = __builtin_amdgcn_mfma_f32_32x32x16_bf16(kf[2 * d0], qr[d0], p0, 0, 0, 0); p1 = __builtin_amdgcn_mfma_f32_32x32x16_bf16(kf[2 * d0 + 1], qr[d0], p1, 0, 0, 0); }
    }
}
template <int NDV>
__device__ __forceinline__ void softmax_tile(f32x16& c0, f32x16& c1, f32x16& negm, float& mref, float& l, f32x16 (&o)[NDV], LAS float* wsf, int r32, int hi, bool first, u32x4 (&pw)[4]) {
    float a = max3f(c0[0], c0[1], c1[0]), b = max3f(c0[2], c0[3], c1[1]); a = max3f(a, c1[2], c1[3]);
#pragma unroll
    for (int r = 4; r < 16; r += 4) { a = max3f(a, c0[r], c0[r + 1]); b = max3f(b, c0[r + 2], c0[r + 3]); a = max3f(a, c1[r], c1[r + 1]); b = max3f(b, c1[r + 2], c1[r + 3]); }
    float rm = max2f(a, b);
    { auto rr = __builtin_amdgcn_permlane32_swap(__float_as_uint(rm), __float_as_uint(rm), false, false); rm = max2f(__uint_as_float(rr[0]), __uint_as_float(rr[1])); }
    if (first || __any(rm > THR)) {
        const float dl = first ? rm : __builtin_fmaxf(rm, 0.f);
        mref += dl;
        const float f = __builtin_amdgcn_exp2f(-dl); l *= f;
        if (hi == 0) wsf[r32] = f;
#pragma unroll
        for (int r = 0; r < 16; ++r) { c0[r] -= dl; c1[r] -= dl; negm[r] = -mref; }
        if (!first) {
#pragma unroll
            for (int r = 0; r < 16; ++r) { const float fa = wsf[crow(r, hi)];
#pragma unroll
                for (int d = 0; d < NDV; ++d) o[d][r] *= fa; }
        }
    }
    float ps = 0.f, ps2 = 0.f, one = 1.f; asm volatile("" : "+v"(one));
#pragma unroll
    for (int ks = 0; ks < 4; ++ks) {
#pragma unroll
        for (int q = 0; q < 4; ++q) {
            const int r = 8 * (ks & 1) + 2 * q;
            const float ea = __builtin_amdgcn_exp2f(ks < 2 ? c0[r] : c1[r]), eb = __builtin_amdgcn_exp2f(ks < 2 ? c0[r + 1] : c1[r + 1]);
            pw[ks][q] = cvtpk_s(ea, eb);
            ps += ea; ps2 = __builtin_fmaf(eb, one, ps2);
        }
    }
    l += ps + ps2;
}
template <int NDV>
__device__ __forceinline__ void pv_tile(const LAS unsigned char* Vs, const u32x4 (&pw)[4], f32x16 (&o)[NDV]) {
#pragma unroll
    for (int ks = 0; ks < 4; ++ks)
#pragma unroll
        for (int d0 = 0; d0 < NDV; ++d0) {
            const v4i16_t lo = __builtin_amdgcn_ds_read_tr16_b64_v4i16((LAS v4i16_t*)(Vs + (d0 * 4 + ks) * 1024));
            const v4i16_t hh = __builtin_amdgcn_ds_read_tr16_b64_v4i16((LAS v4i16_t*)(Vs + (d0 * 4 + ks) * 1024 + 512));
            const bf16x8 vf = (bf16x8){lo[0], lo[1], lo[2], lo[3], hh[0], hh[1], hh[2], hh[3]};
            o[d0] = __builtin_amdgcn_mfma_f32_32x32x16_bf16(__builtin_bit_cast(bf16x8, pw[ks]), vf, o[d0], 0, 0, 0);
        }
}

struct Conv { const float* wgu; const float* wdn; bf16_t* WguT; bf16_t* WdT; int gw, ngw, k, c, pend0, pend1, tick, staged; };
__device__ __forceinline__ void conv_addr(const Conv& cv, int id, const float*& W, int& ldw, char*& WT, int& kb, int& cb, bool& gu) {
    if (id < NCHUNK_GU) { const int e = id >> 11, r = id & 2047; kb = r >> 7; cb = r & 127; W = cv.wgu + (size_t)e * DM * 2 * DFF; ldw = 2 * DFF; WT = (char*)cv.WguT + (size_t)e * 2 * DFF * DM; gu = true; }
    else { const int id2 = id - NCHUNK_GU, e = id2 >> 10, r = id2 & 1023; kb = r >> 6; cb = r & 63; W = cv.wdn + (size_t)e * DFF * DM; ldw = DM; WT = (char*)cv.WdT + (size_t)e * DM * DFF; gu = false; }
}
__device__ __forceinline__ void conv_step(Conv& cv, LAS unsigned char* cs, int lane, bool load_next = true) {
    const int bsel = cv.c & 1; ++cv.c;
    LAS unsigned char* cf = cs + bsel * 4096;
    const int pend = bsel ? cv.pend1 : cv.pend0;
    if (pend >= 0) {
        const float* W; int ldw, kb, cb; char* WT; bool gu; conv_addr(cv, pend, W, ldw, WT, kb, cb, gu);
        const int n = lane >> 2, ks = lane & 3;
        const LAS unsigned char* rb = cf + ks * 1024 + n * 4;
        float v[16];
#pragma unroll
        for (int q = 0; q < 4; ++q)
#pragma unroll
            for (int r = 0; r < 4; ++r) v[4 * q + r] = *(const LAS float*)(rb + q * 256 + ((r + ks) & 3) * 64);
        asm volatile("s_waitcnt lgkmcnt(0)" ::: "memory");
        const int c = cb * 16 + n;
        const int row = gu ? ((c >> 8) * 256 + (c & 1) * 128 + ((c & 255) >> 1)) : c;
        u32x4 o;
        o.x = pk4_fp8(v[0] * W8_SCALE, v[1] * W8_SCALE, v[2] * W8_SCALE, v[3] * W8_SCALE); o.y = pk4_fp8(v[4] * W8_SCALE, v[5] * W8_SCALE, v[6] * W8_SCALE, v[7] * W8_SCALE);
        o.z = pk4_fp8(v[8] * W8_SCALE, v[9] * W8_SCALE, v[10] * W8_SCALE, v[11] * W8_SCALE); o.w = pk4_fp8(v[12] * W8_SCALE, v[13] * W8_SCALE, v[14] * W8_SCALE, v[15] * W8_SCALE);
        *(u32x4*)(WT + (size_t)row * 1024 + kb * 64 + ks * 16) = o;
    }
    int np = -1;
    if (load_next) {
        const int id = cv.k * cv.ngw + cv.gw; ++cv.k;
        if (id < NCHUNK) { const float* W; int ldw, kb, cb; char* WT; bool gu; conv_addr(cv, id, W, ldw, WT, kb, cb, gu);
            const char* src = (const char*)(W + (size_t)kb * 64 * ldw + cb * 16); const int prow = lane >> 2;
#pragma unroll
            for (int i = 0; i < 4; ++i) {
                const unsigned loff = ((unsigned)(16 * i + ((prow & 12) | ((prow - i) & 3))) * (unsigned)ldw + (unsigned)(lane & 3) * 4u) * 4u;
                glds16(src + loff, (unsigned)__builtin_amdgcn_readfirstlane((int)(unsigned)(uintptr_t)(cf + i * 1024))); }
            np = id; cv.staged += 4; }
    }
    if (bsel) cv.pend1 = np; else cv.pend0 = np;
}
__device__ __forceinline__ void conv_drain(Conv& cv, LAS unsigned char* cs, int lane) {
    for (;;) { asm volatile("s_waitcnt vmcnt(0)" ::: "memory"); conv_step(cv, cs, lane); if (cv.pend0 < 0 && cv.pend1 < 0) break; }
}

template <int DQK, int DV, bool CONV>
__device__ __forceinline__ float attn_pass(LAS unsigned char* lds, int wid, int lane, const Src& S, int NT, int my_nt, f32x16 (&o)[DV / 32], Ring& R, const Src& nS, int next_kind, Conv& cv) {
    constexpr int ND0 = DQK / 16, NDV = DV / 32;
    asm volatile("" : "+v"(lane));
    const int r32 = lane & 31, hi = lane >> 5;
    LAS float* wsf = (LAS float*)(lds + WS_OFF + wid * 256);
    if (!R.pre) { issue_tile<DQK, DV>(lds, wid, lane, S, 0, R.s_cur); issue_tile<DQK, DV>(lds, wid, lane, S, 1, R.s_nxt); }
    bf16x8 qr[ND0];
#pragma unroll
    for (int d0 = 0; d0 < ND0; ++d0) qr[d0] = *(const bf16x8*)(S.q + (size_t)r32 * S.qp + d0 * 16 + hi * 8);
    f32x16 negm;
#pragma unroll
    for (int r = 0; r < 16; ++r) negm[r] = 0.f;
#pragma unroll
    for (int d = 0; d < NDV; ++d)
#pragma unroll
        for (int r = 0; r < 16; ++r) o[d][r] = 0.f;
    float mref = 0.f, l = 0.f;
    const int koff_e = (r32 >> 4) * 1024 + (r32 & 15) * 64 + ((hi ^ ((r32 & 15) >> 2)) * 16), koff_o = koff_e ^ 32, voff = ((lane >> 4) & 1) * 32 + (lane & 3) * 8 + (4 * hi + ((lane & 15) >> 2)) * 64;
    asm volatile("s_waitcnt vmcnt(0)" ::: "memory");
    cv.staged = 0;
#pragma unroll
    for (int d0 = 0; d0 < ND0; ++d0) asm volatile("" : "+v"(qr[d0]));
    __syncthreads();
    f32x16 c0, c1;
    int s_cur = R.s_cur, s_nxt = R.s_nxt, s_fill = R.s_fill;
    { bf16x8 kf0[DQK / 8]; k_load<DQK>(lds + K_OFF + s_cur * KSLOT, koff_e, koff_o, kf0); qk_regs<DQK>(kf0, qr, negm, c0, c1); }
    for (int t = 0; t < NT; ++t) {
        if (CONV && cv.staged == 4) asm volatile("s_waitcnt vmcnt(4)" ::: "memory");
        else asm volatile("s_waitcnt vmcnt(0)" ::: "memory");
        cv.staged = 0;
        __syncthreads();
        if (t + 2 < NT) { issue_tile<DQK, DV>(lds, wid, lane, S, t + 2, s_fill); if ((PROBE_REP >> 16) & 1) issue_tile<DQK, DV>(lds, wid, lane, S, t + 2, s_fill); }
        else if (next_kind == 1) issue_tile<64, 128>(lds, wid, lane, nS, t + 2 - NT, s_fill);
        else if (next_kind == 2) issue_tile<96, 64>(lds, wid, lane, nS, t + 2 - NT, s_fill);
        if constexpr (CONV) { if (cv.tick != 0) conv_step(cv, lds + CONV_OFF + wid * CONV_WAVE, lane); cv.tick = (cv.tick == CONV_PERIOD - 1) ? 0 : cv.tick + 1; }
        if ((PROBE_REP >> 19) & 1) __syncthreads();
        if (t < my_nt) {
            u32x4 pw[4]; bf16x8 kf[DQK / 8];
            k_load<DQK>(lds + K_OFF + s_nxt * KSLOT, koff_e, koff_o, kf);
            asm volatile("s_nop 15\n\ts_nop 7" : "+v"(c0), "+v"(c1));
            softmax_tile<NDV>(c0, c1, negm, mref, l, o, wsf, r32, hi, t == 0, pw);
            qk_regs<DQK>(kf, qr, negm, c0, c1);
            if ((PROBE_REP >> 18) & 1) { asm volatile("" : "+v"(c0), "+v"(c1)); qk_regs<DQK>(kf, qr, negm, c0, c1); }
            pv_tile<NDV>(lds + V_OFF + s_cur * VSLOT + voff, pw, o);
            if ((PROBE_REP >> 17) & 1) { u32x4 pz[4];
#pragma unroll
                for (int k = 0; k < 4; ++k) { pz[k] = (u32x4){0u, 0u, 0u, 0u}; asm volatile("" : "+v"(pz[k])); }
                pv_tile<NDV>(lds + V_OFF + s_cur * VSLOT + voff, pz, o); }
        }
        { const int tmp_ = s_cur; s_cur = s_nxt; s_nxt = s_fill; s_fill = tmp_; }
    }
    __syncthreads();
    R.s_cur = s_cur; R.s_nxt = s_nxt; R.s_fill = s_fill; R.pre = (next_kind != 0);
    { auto rr = __builtin_amdgcn_permlane32_swap(__float_as_uint(l), __float_as_uint(l), false, false); l = __uint_as_float(rr[0]) + __uint_as_float(rr[1]); }
    return l;
}

__device__ __forceinline__ void attn_phase(LAS unsigned char* lds, const int wid, int vcu, int G, const bf16_t* PROJ, const bf16_t* QMLA, const bf16_t* KV, bf16_t* ATT, const float* g_sub, float lam, unsigned* o1g, Conv& cv) {
    int lane = lane_id();
    LAS float* wsf = (LAS float*)(lds + WS_OFF + wid * 256);
    unsigned* o1b = o1g + (size_t)blockIdx.x * 16384 + wid * 2048;
    const int nd = vcu < 256 ? (256 - vcu + G - 1) / G : 0, nm = vcu < 512 ? (512 - vcu + G - 1) / G : 0, npass = 4 * nd + 2 * nm;
    Ring R; R.s_cur = 0; R.s_nxt = 1; R.s_fill = 2; R.pre = false;
#define ATT_DECODE(P, KIND, SRC, NTv, MYNT, RQ, HH, CC) do { \
        if ((P) < 4 * nd) { const int it_ = vcu + ((P) >> 2) * G, half_ = ((P) >> 1) & 1, c_ = (P) & 1, bh_ = it_ >> 2, s_ = it_ & 3, b_ = bh_ >> 2, h_ = bh_ & 3, qb_ = half_ ? 7 - s_ : s_; \
            const size_t r0_ = (size_t)b_ * SEQ, rq_ = r0_ + qb_ * 256 + wid * 32; \
            KIND = 1; NTv = 4 * qb_ + 4; MYNT = 4 * qb_ + (wid >> 1) + 1; RQ = rq_; HH = h_; CC = c_; \
            SRC.qp = PROJ_LD; SRC.k1p = PROJ_LD; SRC.k2p = PROJ_LD; SRC.vp = PROJ_LD; SRC.v = PROJ + r0_ * PROJ_LD + P_DV + h_ * 128; \
            SRC.q = PROJ + rq_ * PROJ_LD + P_DQ + h_ * 128 + c_ * 64; SRC.k1 = PROJ + r0_ * PROJ_LD + P_DK + h_ * 128 + c_ * 64; SRC.k2 = SRC.k1; } \
        else if ((P) < npass) { const int q_ = (P) - 4 * nd, it_ = vcu + (q_ >> 1) * G, half_ = q_ & 1, bh_ = it_ >> 2, s_ = it_ & 3, b_ = bh_ >> 3, h_ = bh_ & 7, qb_ = half_ ? 7 - s_ : s_; \
            const size_t r0_ = (size_t)b_ * SEQ, rq_ = r0_ + qb_ * 256 + wid * 32; \
            KIND = 2; NTv = 4 * qb_ + 4; MYNT = 4 * qb_ + (wid >> 1) + 1; RQ = rq_; HH = h_; CC = 0; \
            SRC.q = QMLA + rq_ * 768 + h_ * 96; SRC.qp = 768; SRC.k1 = KV + r0_ * 1024 + h_ * 128; SRC.k1p = 1024; SRC.k2 = PROJ + r0_ * PROJ_LD + P_KPE; SRC.k2p = PROJ_LD; \
            SRC.v = KV + r0_ * 1024 + h_ * 128 + 64; SRC.vp = 1024; } \
        else { KIND = 0; } } while (0)
    for (int p = 0; p < npass; ++p) {
        int kind, NT, my_nt, h, c, nkind, nNT, nmy, nh, nc; size_t rq, nrq; Src S, nS;
        ATT_DECODE(p, kind, S, NT, my_nt, rq, h, c);
        nS = S; ATT_DECODE(p + 1, nkind, nS, nNT, nmy, nrq, nh, nc);
        (void)nNT; (void)nmy; (void)nrq; (void)nh; (void)nc;
        if (kind == 1) {
            f32x16 o[4];
            const float l = attn_pass<64, 128, false>(lds, wid, lane, S, NT, my_nt, o, R, nS, nkind, cv);
            asm volatile("" : "+v"(lane)); const int r32 = lane & 31, hi = lane >> 5; unsigned* o1s = o1b + lane;
            if (hi == 0) wsf[32 + r32] = 1.f / l;
            if (c == 0) {
#pragma unroll
                for (int r = 0; r < 16; r += 2) { const float rl0 = wsf[32 + crow(r, hi)], rl1 = wsf[32 + crow(r + 1, hi)];
#pragma unroll
                    for (int d = 0; d < 4; ++d) o1s[(d * 8 + (r >> 1)) * 64] = pk2(o[d][r] * rl0, o[d][r + 1] * rl1); }
            } else {
                LAS unsigned char* stg = lds + CONV_OFF + wid * CONV_WAVE;
                float gs[4];
#pragma unroll
                for (int d = 0; d < 4; ++d) gs[d] = g_sub[d * 32 + r32];
#pragma unroll
                for (int r = 0; r < 16; ++r) { const float rl = wsf[32 + crow(r, hi)];
                    float ss = 0.f; float v[4];
#pragma unroll
                    for (int d = 0; d < 4; ++d) { const unsigned w = o1s[(d * 8 + (r >> 1)) * 64]; const float o1 = __builtin_bit_cast(float, (r & 1) ? (w & 0xffff0000u) : (w << 16));
                        v[d] = o1 - lam * (o[d][r] * rl); ss += v[d] * v[d]; }
                    ss += __shfl_xor(ss, 1); ss += __shfl_xor(ss, 2); ss += __shfl_xor(ss, 4); ss += __shfl_xor(ss, 8); ss += __shfl_xor(ss, 16);
                    const float rinv = rsqrtf(ss * (1.f / 128.f) + 1e-5f) * (1.f - LAMBDA_INIT);
#pragma unroll
                    for (int d = 0; d < 4; ++d) *(LAS unsigned char*)(stg + crow(r, hi) * 128 + (d * 32 + r32)) = (unsigned char)__builtin_amdgcn_cvt_pk_fp8_f32(v[d] * rinv * gs[d], 0.f, 0, false); }
                asm volatile("s_waitcnt lgkmcnt(0)" ::: "memory");
#pragma unroll
                for (int j = 0; j < 4; ++j) { const int idx = lane + 64 * j, row = idx >> 3, ch = idx & 7;
                    const u32x4 vv = *(const LAS u32x4*)(stg + row * 128 + ch * 16);
                    *(u32x4*)((char*)ATT + (rq + row) * DM + 512 + h * 128 + ch * 16) = vv; }
                asm volatile("s_waitcnt lgkmcnt(0)" ::: "memory");
            }
        } else {
            f32x16 o[2];
            const float l = attn_pass<96, 64, true>(lds, wid, lane, S, NT, my_nt, o, R, nS, nkind, cv);
            asm volatile("" : "+v"(lane)); const int r32 = lane & 31, hi = lane >> 5;
            if (hi == 0) wsf[32 + r32] = 1.f / l;
            {
                LAS unsigned char* stg = lds + V_OFF + R.s_fill * VSLOT + wid * 2048;
#pragma unroll
                for (int r = 0; r < 16; ++r) { const float rl = wsf[32 + crow(r, hi)];
#pragma unroll
                    for (int d = 0; d < 2; ++d) *(LAS unsigned char*)(stg + crow(r, hi) * 64 + (d * 32 + r32)) = (unsigned char)__builtin_amdgcn_cvt_pk_fp8_f32(o[d][r] * rl, 0.f, 0, false); }
                asm volatile("s_waitcnt lgkmcnt(0)" ::: "memory");
#pragma unroll
                for (int j = 0; j < 2; ++j) { const int idx = lane + 64 * j, row = idx >> 2, ch = idx & 3;
                    const u32x4 vv = *(const LAS u32x4*)(stg + row * 64 + ch * 16);
                    *(u32x4*)((char*)ATT + (rq + row) * DM + h * 64 + ch * 16) = vv; }
                asm volatile("s_waitcnt lgkmcnt(0)" ::: "memory");
            }
        }
    }
#undef ATT_DECODE
    conv_drain(cv, lds + CONV_OFF + wid * CONV_WAVE, lane);
}
}

constexpr int RING_BYTES = 155648;
constexpr int LDSCTL_OFF = RING_BYTES;
constexpr int LDS_TEXP = RING_BYTES + 256;
constexpr int LDS_IDX = RING_BYTES + 4096;
constexpr int LDS_BYTES = 163840;
constexpr int NWAVES = 8;
constexpr int N_PHASES = 11;

struct MkArgs {
    const float* in[25]; float* out; unsigned char* ws; long long ph_lo_hi;
};
static_assert(sizeof(MkArgs) == 28 * 8, "MkArgs has padding");

__device__ __forceinline__ int src_col_win(int nd) { return nd < 640 ? nd : (nd < 2176 ? nd + 32 : (nd < 2208 ? nd - 2176 + 640 : -1)); }
__device__ __forceinline__ int src_col_gu(int nd) { const int pn = nd >> 8, r = nd & 255; return r < 128 ? 2 * (128 * pn + r) : 2 * (128 * pn + r - 128) + 1; }

template <int MAP>
__device__ __forceinline__ void p0_tr_item(const float* __restrict__ W, int ldw, int K, bf16_t* WT, int n0, int k0, const float* __restrict__ g, LAS float* scr, int lane, bool out8 = false) {
    const int nd = n0 + (lane & 31);
    const int sc = MAP == 0 ? nd : (MAP == 1 ? src_col_win(nd) : src_col_gu(nd));
#pragma unroll 8
    for (int i = 0; i < 32; ++i) { const int kk = 2 * i + (lane >> 5); float v = 0.f; if (sc >= 0) v = W[(size_t)(k0 + kk) * ldw + sc]; if (g) v *= g[k0 + kk]; scr[kk * 33 + (lane & 31)] = v; }
    asm volatile("s_waitcnt lgkmcnt(0)" ::: "memory");
    const int c = lane & 7;
#pragma unroll
    for (int j = 0; j < 4; ++j) { const int n = (lane >> 3) + 8 * j; const LAS float* s = scr + (8 * c) * 33 + n;
        if (out8) { u32x2 o; o.x = pk4_fp8(s[0 * 33] * W8_SCALE, s[1 * 33] * W8_SCALE, s[2 * 33] * W8_SCALE, s[3 * 33] * W8_SCALE); o.y = pk4_fp8(s[4 * 33] * W8_SCALE, s[5 * 33] * W8_SCALE, s[6 * 33] * W8_SCALE, s[7 * 33] * W8_SCALE);
            *(u32x2*)((char*)WT + (size_t)(n0 + n) * K + k0 + 8 * c) = o; }
        else { u32x4 o; o.x = pk2(s[0 * 33], s[1 * 33]); o.y = pk2(s[2 * 33], s[3 * 33]); o.z = pk2(s[4 * 33], s[5 * 33]); o.w = pk2(s[6 * 33], s[7 * 33]);
            *(u32x4*)(WT + (size_t)(n0 + n) * K + k0 + 8 * c) = o; } }
    asm volatile("s_waitcnt lgkmcnt(0)" ::: "memory");
}
__global__ void __launch_bounds__(NWAVES * 64, 2) mk_fwd(MkArgs args) {
    extern __shared__ __attribute__((aligned(16))) unsigned char lds_raw[];
    LAS unsigned char* lds = (LAS unsigned char*)lds_raw;
    const int wave = __builtin_amdgcn_readfirstlane((int)(threadIdx.x >> 6)); int lane = lane_id(), tid = wave * 64 + lane;
#define RELANE() do { lane = lane_id(); tid = wave * 64 + lane; } while (0)
    const int G = gridDim.x; const int bx = blockIdx.x; const int vcu = (G % 8 == 0) ? (bx % 8) * (G / 8) + bx / 8 : bx;
    const int gw = vcu * NWAVES + wave, NGW = G * NWAVES;
    unsigned char* ws = args.ws;
    unsigned* ctl = (unsigned*)(ws + F_CTL);
    const int ph_lo = (int)(args.ph_lo_hi & 0xffff), ph_hi = (int)((args.ph_lo_hi >> 16) & 0xffff), li = (int)((args.ph_lo_hi >> 32) & 0xffff);
    const float* x = args.in[0]; const float* cvec = args.in[1]; const int* pos = (const int*)args.in[2];
    const float* w_ada = args.in[3]; const float* b_ada = args.in[4]; const float* g1 = args.in[5];
    const float* w_in = args.in[6]; const float* g_q = args.in[7]; const float* w_uq = args.in[8];
    const float* g_kv = args.in[9]; const float* w_ukv = args.in[10];
    const float* g_sub = args.in[15]; const float* w_out = args.in[16]; const float* g2 = args.in[17];
    const float* w_r = args.in[18]; const float* b_r = args.in[19]; const float* w_gu = args.in[20]; const float* b_gu = args.in[21];
    const float* w_dn = args.in[22]; const float* b_dn = args.in[23]; const float* g_fin = args.in[24];
    float* mod = (float*)(ws + F_MOD); float* lamp = (float*)(ws + F_MISC); float* rope = (float*)(ws + F_ROPE); float* ssqp = (float*)(ws + F_SSQP);
    bf16_t* WinT = (bf16_t*)(ws + F_WIN); bf16_t* WuqT = (bf16_t*)(ws + F_WUQ); bf16_t* WukvT = (bf16_t*)(ws + F_WUKV); bf16_t* WoutT = (bf16_t*)(ws + F_WOUT);
    bf16_t* WguT = (bf16_t*)(ws + F_WGU); bf16_t* WdT = (bf16_t*)(ws + F_WD);
    bf16_t* H1 = (bf16_t*)(ws + F_H1); bf16_t* PROJ = (bf16_t*)(ws + F_PROJ);

    for (int u = tid; u < 64; u += NWAVES * 64) ((LAS unsigned*)(lds + LDSCTL_OFF))[u] = 0u;
    __syncthreads();
    XcdBarrier bar = xcd_barrier_post(ctl + CW_BAR + li * XCD_BAR_WORDS, (volatile LAS unsigned*)(lds + LDSCTL_OFF) + 8);
#ifndef PROBE_REP
#define PROBE_REP 0
#endif
#define REPS(k) (((PROBE_REP >> (k)) & 1) ? 2 : 1)
#define IN(k) (ph_lo <= (k) && (k) < ph_hi)
#define SEAM(k) do { if (IN(k) && IN((k) + 1)) xcd_barrier(bar); } while (0)

    float wv[32]; float rpos = 0.f; float rinvf[6];
    int w_n0 = 0, w_k0 = 0, w_K = 0; char* w_WT = nullptr; bool w_has = false, w_out8 = false, rp_has = false;
    constexpr int I_IN = 16 * 72, I_UQ = 6 * 24, I_UKV = 4 * 32, I_OUT = 16 * 32;
    constexpr int NITEMS = I_IN + I_UQ + I_UKV + I_OUT;
    if (IN(0)) {
        LAS float* scr = (LAS float*)(lds + wave * 16384);
        float* modp = (float*)(ws + F_MODP); unsigned* modc = ctl + CW_MODC;
        if (G >= 192) {
            if (vcu < 192) {
                const int cb = vcu % 96, hf = vcu / 96, kc = 8 * hf + wave;
#pragma unroll
                for (int j = 0; j < 16; ++j) { const int kk = (lane >> 4) + 4 * j; const float cv = cvec[(lane & 15) * DM + kc * 64 + kk]; scr[kk * 16 + (lane & 15)] = cv / (1.f + __expf(-cv)); }
                asm volatile("s_waitcnt lgkmcnt(0)" ::: "memory");
                float acc[16];
#pragma unroll
                for (int b = 0; b < 16; ++b) acc[b] = 0.f;
                const float* wp = w_ada + (size_t)(kc * 64) * NMOD + cb * 64 + lane;
#pragma unroll 1
                for (int k16 = 0; k16 < 64; k16 += 16) {
                    float wv[16];
#pragma unroll
                    for (int kk = 0; kk < 16; ++kk) wv[kk] = wp[(size_t)(k16 + kk) * NMOD];
#pragma unroll
                    for (int kk = 0; kk < 16; ++kk) { const float w = wv[kk];
#pragma unroll
                        for (int b4 = 0; b4 < 4; ++b4) { const f32x4 s4 = *(const LAS f32x4*)(scr + (k16 + kk) * 16 + 4 * b4); acc[4 * b4] += s4[0] * w; acc[4 * b4 + 1] += s4[1] * w; acc[4 * b4 + 2] += s4[2] * w; acc[4 * b4 + 3] += s4[3] * w; } }
                }
                LAS float* dump = scr + 2304;
#pragma unroll
                for (int b = 0; b < 16; ++b) dump[b * 64 + lane] = acc[b];
                __syncthreads();
                {
                    float s0 = 0.f, s1 = 0.f;
#pragma unroll
                    for (int v = 0; v < 8; ++v) { const LAS float* d = (const LAS float*)(lds + v * 16384) + 2304; s0 += d[(2 * wave) * 64 + lane]; s1 += d[(2 * wave + 1) * 64 + lane]; }
                    float* pp = modp + (size_t)(hf * 16 + 2 * wave) * NMOD + cb * 64 + lane;
                    __hip_atomic_store(pp, s0, __ATOMIC_RELAXED, __HIP_MEMORY_SCOPE_AGENT); __hip_atomic_store(pp + NMOD, s1, __ATOMIC_RELAXED, __HIP_MEMORY_SCOPE_AGENT);
                    asm volatile("s_waitcnt vmcnt(0)" ::: "memory");
                }
                __syncthreads();
                if (wave == 0) {
                    unsigned old = 0u;
                    if (lane == 0) old = __hip_atomic_fetch_add(modc + cb, 1u, __ATOMIC_RELAXED, __HIP_MEMORY_SCOPE_AGENT);
                    old = (unsigned)__builtin_amdgcn_readfirstlane((int)old);
                    if (old == 1u) {
                        const float bias = b_ada[cb * 64 + lane];
                        const float* qq = modp + cb * 64 + lane;
                        float t[2][16];
#pragma unroll
                        for (int h2 = 0; h2 < 2; ++h2)
#pragma unroll
                            for (int b = 0; b < 16; ++b) t[h2][b] = __hip_atomic_load(qq + (size_t)(h2 * 16 + b) * NMOD, __ATOMIC_RELAXED, __HIP_MEMORY_SCOPE_AGENT);
#pragma unroll
                        for (int b = 0; b < 16; ++b) __hip_atomic_store(mod + b * NMOD + cb * 64 + lane, (bias + t[0][b]) + t[1][b], __ATOMIC_RELAXED, __HIP_MEMORY_SCOPE_AGENT);
                        asm volatile("s_waitcnt vmcnt(0)" ::: "memory");
                        if (lane == 0) (void)__hip_atomic_fetch_add(ctl + CW_MODD, 1u, __ATOMIC_RELAXED, __HIP_MEMORY_SCOPE_AGENT);
                    }
                }
                asm volatile("s_waitcnt lgkmcnt(0)" ::: "memory");
            }
        } else
        for (int it = gw; it < 96 * 16; it += NGW) {
            const int cb = it % 96, kc = it / 96;
#pragma unroll
            for (int j = 0; j < 16; ++j) { const int kk = (lane >> 4) + 4 * j; const float cv = cvec[(lane & 15) * DM + kc * 64 + kk]; scr[kk * 16 + (lane & 15)] = cv / (1.f + __expf(-cv)); }
            asm volatile("s_waitcnt lgkmcnt(0)" ::: "memory");
            float acc[16];
#pragma unroll
            for (int b = 0; b < 16; ++b) acc[b] = 0.f;
            const float* wp = w_ada + (size_t)(kc * 64) * NMOD + cb * 64 + lane;
#pragma unroll 1
            for (int k16 = 0; k16 < 64; k16 += 16) {
                float wv[16];
#pragma unroll
                for (int kk = 0; kk < 16; ++kk) wv[kk] = wp[(size_t)(k16 + kk) * NMOD];
#pragma unroll
                for (int kk = 0; kk < 16; ++kk) { const float w = wv[kk];
#pragma unroll
                    for (int b4 = 0; b4 < 4; ++b4) { const f32x4 s4 = *(const LAS f32x4*)(scr + (k16 + kk) * 16 + 4 * b4); acc[4 * b4] += s4[0] * w; acc[4 * b4 + 1] += s4[1] * w; acc[4 * b4 + 2] += s4[2] * w; acc[4 * b4 + 3] += s4[3] * w; } }
            }
            float* pp = modp + (size_t)kc * 16 * NMOD + cb * 64 + lane;
#pragma unroll
            for (int b = 0; b < 16; ++b) __hip_atomic_store(pp + b * NMOD, acc[b], __ATOMIC_RELAXED, __HIP_MEMORY_SCOPE_AGENT);
            asm volatile("s_waitcnt vmcnt(0)" ::: "memory");
            unsigned old = 0u;
            if (lane == 0) old = __hip_atomic_fetch_add(modc + cb, 1u, __ATOMIC_RELAXED, __HIP_MEMORY_SCOPE_AGENT);
            old = (unsigned)__builtin_amdgcn_readfirstlane((int)old);
            if (old == 15u) {
                const float bias = b_ada[cb * 64 + lane];
#pragma unroll
                for (int b = 0; b < 16; ++b) acc[b] = bias;
                const float* qq = modp + cb * 64 + lane;
#pragma unroll 1
                for (int k = 0; k < 16; k += 4) {
                    float t[4][16];
#pragma unroll
                    for (int kk = 0; kk < 4; ++kk)
#pragma unroll
                        for (int b = 0; b < 16; ++b) t[kk][b] = __hip_atomic_load(qq + (size_t)((k + kk) * 16 + b) * NMOD, __ATOMIC_RELAXED, __HIP_MEMORY_SCOPE_AGENT);
#pragma unroll
                    for (int kk = 0; kk < 4; ++kk)
#pragma unroll
                        for (int b = 0; b < 16; ++b) acc[b] += t[kk][b];
                }
#pragma unroll
                for (int b = 0; b < 16; ++b) __hip_atomic_store(mod + b * NMOD + cb * 64 + lane, acc[b], __ATOMIC_RELAXED, __HIP_MEMORY_SCOPE_AGENT);
                asm volatile("s_waitcnt vmcnt(0)" ::: "memory");
                if (lane == 0) (void)__hip_atomic_fetch_add(ctl + CW_MODD, 1u, __ATOMIC_RELAXED, __HIP_MEMORY_SCOPE_AGENT);
            }
            asm volatile("s_waitcnt lgkmcnt(0)" ::: "memory");
        }
        {   const int idx = gw * 64 + lane; rp_has = idx < MTOK * 4;
            if (rp_has) { rpos = (float)pos[idx >> 2]; const int q6 = (idx & 3) * 6;
#pragma unroll
                for (int j = 0; j < 6; ++j) { const int f = q6 + j; rinvf[j] = f < 16 ? INVF16[f] : INVF8[f - 16]; } }
        }
        if (gw == 0) {
            const float a = wave_sum(args.in[11][lane] * args.in[12][lane]), b = wave_sum(args.in[13][lane] * args.in[14][lane]);
            if (lane == 0) *lamp = expf(a) - expf(b) + LAMBDA_INIT;
        }
        if (gw < NITEMS) {
            int r = gw; const float* W; int ldw; const float* g = nullptr; int sc; const int nl = lane & 31;
            if (r < I_IN) { W = w_in; ldw = INCOLS; w_K = DM; w_WT = (char*)WinT; w_n0 = (r % 72) * 32; w_k0 = (r / 72) * 64; w_out8 = true; sc = src_col_win(w_n0 + nl); }
            else if ((r -= I_IN) < I_UQ) { W = w_uq; ldw = 768; w_K = QRANK; w_WT = (char*)WuqT; w_n0 = (r % 24) * 32; w_k0 = (r / 24) * 64; g = g_q; sc = w_n0 + nl; }
            else if ((r -= I_UQ) < I_UKV) { W = w_ukv; ldw = 1024; w_K = KVRANK; w_WT = (char*)WukvT; w_n0 = (r % 32) * 32; w_k0 = (r / 32) * 64; g = g_kv; sc = w_n0 + nl; }
            else { r -= I_UKV; W = w_out; ldw = DM; w_K = DM; w_WT = (char*)WoutT; w_n0 = (r % 32) * 32; w_k0 = (r / 32) * 64; w_out8 = true; sc = w_n0 + nl; }
#pragma unroll
            for (int i = 0; i < 32; ++i) { const int kk = 2 * i + (lane >> 5); float v = 0.f; if (sc >= 0) v = W[(size_t)(w_k0 + kk) * ldw + sc]; if (g) v *= g[w_k0 + kk]; wv[i] = v; }
            w_has = true;
        }
    }
    if (IN(0) && IN(1)) { __syncthreads(); unsigned sp_ = 0u; while (xb_ld(ctl + CW_MODD) < 96u) { __builtin_amdgcn_s_sleep(1); if (++sp_ > XB_SPIN_CAP) break; } }
    RELANE();
    if (IN(1)) {
        for (int rep = 0; rep < REPS(1); ++rep) {
        const int rpw = (MTOK + NGW - 1) / NGW, m0 = gw * rpw, m1 = (m0 + rpw < MTOK) ? m0 + rpw : MTOK;
        f32x4 gv[4], sc[4], sh[4]; int bcur = -1;
#pragma unroll
        for (int j = 0; j < 4; ++j) gv[j] = *(const f32x4*)(g1 + 4 * lane + 256 * j);
        for (int m = m0; m < m1; m += 2) {
            const bool two = (m + 1 < m1);
            const f32x4* xr0 = (const f32x4*)(x + (size_t)m * DM) + lane; const f32x4* xr1 = (const f32x4*)(x + (size_t)(two ? m + 1 : m) * DM) + lane;
            f32x4 v0[4], v1[4];
#pragma unroll
            for (int j = 0; j < 4; ++j) { v0[j] = xr0[64 * j]; v1[j] = xr1[64 * j]; }
#pragma unroll
            for (int rr = 0; rr < 2; ++rr) {
                if (rr == 1 && !two) break;
                const int mm = m + rr, b = mm / SEQ;
                if (b != bcur) { bcur = b;
#pragma unroll
                    for (int j = 0; j < 4; ++j)
#pragma unroll
                        for (int q = 0; q < 4; ++q) { sc[j][q] = __hip_atomic_load((float*)mod + b * NMOD + DM + 4 * lane + 256 * j + q, __ATOMIC_RELAXED, __HIP_MEMORY_SCOPE_AGENT);
                            sh[j][q] = __hip_atomic_load((float*)mod + b * NMOD + 4 * lane + 256 * j + q, __ATOMIC_RELAXED, __HIP_MEMORY_SCOPE_AGENT); } }
                float ssum = 0.f;
#pragma unroll
                for (int j = 0; j < 4; ++j) { const f32x4 t = rr ? v1[j] : v0[j]; ssum += (t[0] * t[0] + t[1] * t[1]) + (t[2] * t[2] + t[3] * t[3]); }
                const float rinv = rsqrtf(wave_sum(ssum) * (1.f / DM) + 1e-6f);
                unsigned* o4 = (unsigned*)((char*)H1 + (size_t)mm * DM) + lane;
#pragma unroll
                for (int j = 0; j < 4; ++j) { const f32x4 t = rr ? v1[j] : v0[j]; f32x4 o;
#pragma unroll
                    for (int q = 0; q < 4; ++q) o[q] = t[q] * rinv * gv[j][q] * (1.f + sc[j][q]) + sh[j][q];
                    o4[64 * j] = pk4_fp8(o[0], o[1], o[2], o[3]); }
            }
        }
        }
    }
    if (IN(0)) {
        LAS float* scr = (LAS float*)(lds + wave * 16384);
        if (w_has) {
#pragma unroll
            for (int i = 0; i < 32; ++i) { const int kk = 2 * i + (lane >> 5); scr[kk * 33 + (lane & 31)] = wv[i]; }
            asm volatile("s_waitcnt lgkmcnt(0)" ::: "memory");
            const int c = lane & 7;
#pragma unroll
            for (int j = 0; j < 4; ++j) { const int n = (lane >> 3) + 8 * j; const LAS float* sq = scr + (8 * c) * 33 + n;
                if (w_out8) { u32x2 o; o.x = pk4_fp8(sq[0 * 33] * W8_SCALE, sq[1 * 33] * W8_SCALE, sq[2 * 33] * W8_SCALE, sq[3 * 33] * W8_SCALE); o.y = pk4_fp8(sq[4 * 33] * W8_SCALE, sq[5 * 33] * W8_SCALE, sq[6 * 33] * W8_SCALE, sq[7 * 33] * W8_SCALE);
                    *(u32x2*)(w_WT + (size_t)(w_n0 + n) * w_K + w_k0 + 8 * c) = o; }
                else { u32x4 o; o.x = pk2(sq[0 * 33], sq[1 * 33]); o.y = pk2(sq[2 * 33], sq[3 * 33]); o.z = pk2(sq[4 * 33], sq[5 * 33]); o.w = pk2(sq[6 * 33], sq[7 * 33]);
                    *(u32x4*)(w_WT + ((size_t)(w_n0 + n) * w_K + w_k0 + 8 * c) * 2) = o; } }
            asm volatile("s_waitcnt lgkmcnt(0)" ::: "memory");
        }
        for (int it = gw + NGW; it < NITEMS; it += NGW) {
            int r = it;
            if (r < I_IN) { p0_tr_item<1>(w_in, INCOLS, DM, WinT, (r % 72) * 32, (r / 72) * 64, nullptr, scr, lane, true); continue; } r -= I_IN;
            if (r < I_UQ) { p0_tr_item<0>(w_uq, 768, QRANK, WuqT, (r % 24) * 32, (r / 24) * 64, g_q, scr, lane); continue; } r -= I_UQ;
            if (r < I_UKV) { p0_tr_item<0>(w_ukv, 1024, KVRANK, WukvT, (r % 32) * 32, (r / 32) * 64, g_kv, scr, lane); continue; } r -= I_UKV;
            p0_tr_item<0>(w_out, DM, DM, WoutT, (r % 32) * 32, (r / 32) * 64, nullptr, scr, lane, true);
        }
        for (int idx = gw * 64 + lane, first = 1; idx < MTOK * 4; idx += NGW * 64, first = 0) {
            const int m = idx >> 2, q6 = (idx & 3) * 6;
            const float pf = first ? rpos : (float)pos[m];
            float cs[12];
#pragma unroll
            for (int j = 0; j < 6; ++j) { const int f = q6 + j;
                const float invf = first ? rinvf[j] : (f < 16 ? INVF16[f] : INVF8[f - 16]);
                const float ang = pf * invf;
                double rev = (double)ang * 0.15915494309189533577; rev -= rint(rev);
                cs[2 * j] = __builtin_amdgcn_cosf((float)rev); cs[2 * j + 1] = __builtin_amdgcn_sinf((float)rev); }
            f32x4* rp = (f32x4*)(rope + (size_t)m * 48 + 2 * q6);
#pragma unroll
            for (int j = 0; j < 3; ++j) rp[j] = (f32x4){cs[4 * j], cs[4 * j + 1], cs[4 * j + 2], cs[4 * j + 3]};
        }
    }
    SEAM(1); RELANE();
    if (IN(2)) {
        pg8::Gemm g{H1, WinT, DM / 2, DM / 2}; pg8::StaticOrder S; S.init(MTOK, PROJ_LD, G, bx, REPS(2));
        pg8::EpiProj E{PROJ, rope, ssqp};
        pg8::gemm_phase<pg8::EpiProj, pg8::StaticOrder, true, true, false, true>(lds, wave, g, S, E);
    }
    SEAM(2); RELANE();
    if (IN(3)) {
        bf16_t* QMLA = (bf16_t*)(ws + F_QMLA); bf16_t* KV = (bf16_t*)(ws + F_KV);
        { pg8::Gemm g{PROJ + P_CQ, WuqT, PROJ_LD, QRANK}; pg8::StaticOrder S; S.init(MTOK, 768, G, bx, REPS(3));
          pg8::EpiUp<true> E{QMLA, rope, ssqp};
          pg8::gemm_phase<pg8::EpiUp<true>, pg8::StaticOrder, true, true>(lds, wave, g, S, E); }
        { pg8::Gemm g{PROJ + P_CKV, WukvT, PROJ_LD, KVRANK}; pg8::StaticOrder S; S.init(MTOK, 1024, G, bx, REPS(3));
          pg8::EpiUp<false> E{KV, rope, ssqp};
          pg8::gemm_phase<pg8::EpiUp<false>, pg8::StaticOrder, true, true>(lds, wave, g, S, E); }
    }
    SEAM(3); RELANE();
    if (IN(4)) for (int rep = 0; rep < REPS(4); ++rep) {
        att::Conv cv; cv.wgu = w_gu; cv.wdn = w_dn; cv.WguT = WguT; cv.WdT = WdT; cv.gw = gw; cv.ngw = NGW; cv.k = 0; cv.c = 0; cv.pend0 = -1; cv.pend1 = -1; cv.tick = 0; cv.staged = 0;
        att::attn_phase(lds, wave, vcu, G, PROJ, (const bf16_t*)(ws + F_QMLA), (const bf16_t*)(ws + F_KV), (bf16_t*)(ws + F_ATT), g_sub, *lamp, (unsigned*)(ws + F_O1S), cv);
    }
    SEAM(4); RELANE();
    bf16_t* MIXG = (bf16_t*)(ws + F_X1);
    if (IN(5)) {
        pg8::Gemm g{(const bf16_t*)(ws + F_ATT), WoutT, DM / 2, DM / 2}; pg8::StaticOrder S; S.init(MTOK, DM, G, bx, REPS(5));
        pg8::EpiOut E{mod, MIXG, x};
        pg8::gemm_phase<pg8::EpiOut, pg8::StaticOrder, true, true, false, true>(lds, wave, g, S, E);
    }
    SEAM(5); RELANE();
    bf16_t* H2 = (bf16_t*)(ws + F_H2);
    int* topi = (int*)(ws + F_TOPI); float* topw = (float*)(ws + F_TOPW); int* tpos = (int*)(ws + F_TPOS);
    unsigned* ecnt = ctl + CW_CNT;
    if (IN(6)) {
        constexpr int HP = 1032;
        constexpr int SLOTB = 16 * HP * 2;
        LAS float* red = (LAS float*)(lds + 99328);
        LAS int* lcnt = (LAS int*)(lds + 99328 + 32768);
        LAS int* gbs = lcnt + 32;
        LAS int* lsel = lcnt + 64;
        LAS int* lpos = lsel + 1024;
        LAS float* lwt = (LAS float*)(lpos + 1024);
        int* list = (int*)(ws + F_LIST); float* lw = (float*)(ws + F_LW);
        const int li = lane & 15, lq = lane >> 4;
        bf16x8 wreg[4][2];
#pragma unroll
        for (int sidx = 0; sidx < 4; ++sidx)
#pragma unroll
            for (int nb = 0; nb < 2; ++nb) { float t[8];
#pragma unroll
                for (int i = 0; i < 8; ++i) t[i] = w_r[(size_t)(128 * wave + 32 * sidx + 8 * lq + i) * NEXP + nb * 16 + li];
                u32x4 p; p.x = pk2(t[0], t[1]); p.y = pk2(t[2], t[3]); p.z = pk2(t[4], t[5]); p.w = pk2(t[6], t[7]);
                wreg[sidx][nb] = __builtin_bit_cast(bf16x8, p); }
        const int e = lane & 31;
        const float be = b_r[e];
        if (tid < 32) lcnt[tid] = 0;
        __syncthreads();
        int nloc = 0;
        const int ntw = (MTOK / 16 + G - 1) / G, tl0 = vcu * ntw, tl1 = (tl0 + ntw < MTOK / 16) ? tl0 + ntw : MTOK / 16;
        const int NT = tl1 > tl0 ? tl1 - tl0 : 0;
        f32x4 gs2[4], sh2[4]; int bcur = -1;
        auto dma = [&](const int jt) __attribute__((always_inline)) {
            LAS unsigned char* sb = lds + (jt % 3) * SLOTB;
#pragma unroll
            for (int rr = 0; rr < 2; ++rr) { const char* src = (const char*)(MIXG + (size_t)((tl0 + jt) * 16 + 2 * wave + rr) * DM) + lane_id() * 16;
#pragma unroll
                for (int pc = 0; pc < 2; ++pc) att::glds16(src + pc * 1024, (unsigned)__builtin_amdgcn_readfirstlane((int)(unsigned)(uintptr_t)(sb + (2 * wave + rr) * (HP * 2) + pc * 1024))); }
        };
        for (int rep6 = 0; rep6 < REPS(6); ++rep6) {
        const bool live = (rep6 == REPS(6) - 1);
        if (NT > 0) dma(0);
        auto stageA = [&](const int jt) __attribute__((always_inline)) {
            LAS unsigned char* sb = lds + (jt % 3) * SLOTB;
            if (jt + 1 < NT) asm volatile("s_waitcnt vmcnt(4)" ::: "memory");
            else asm volatile("s_waitcnt vmcnt(0)" ::: "memory");
#pragma unroll
            for (int rr = 0; rr < 2; ++rr) {
                const int m = (tl0 + jt) * 16 + 2 * wave + rr;
                f32x4 v[4]; float ssum = 0.f;
                LAS unsigned char* rowp = sb + (2 * wave + rr) * (HP * 2) + lane * 8;
#pragma unroll
                for (int j = 0; j < 4; ++j) { const u32x2 w = *(const LAS u32x2*)(rowp + 512 * j);
                    v[j][0] = __builtin_bit_cast(float, w.x << 16); v[j][1] = __builtin_bit_cast(float, w.x & 0xffff0000u); v[j][2] = __builtin_bit_cast(float, w.y << 16); v[j][3] = __builtin_bit_cast(float, w.y & 0xffff0000u);
                    ssum += (v[j][0] * v[j][0] + v[j][1] * v[j][1]) + (v[j][2] * v[j][2] + v[j][3] * v[j][3]); }
                const float rinv = rsqrtf(wave_sum(ssum) * (1.f / DM) + 1e-6f);
                unsigned* o4 = (unsigned*)((char*)H2 + (size_t)m * DM) + lane;
#pragma unroll
                for (int j = 0; j < 4; ++j) {
                    f32x4 o;
#pragma unroll
                    for (int q = 0; q < 4; ++q) o[q] = (v[j][q] * rinv) * gs2[j][q] + sh2[j][q];
                    o4[64 * j] = pk4_fp8(o[0], o[1], o[2], o[3]);
                    u32x2 hp; hp.x = pk2(o[0], o[1]); hp.y = pk2(o[2], o[3]); *(LAS u32x2*)(rowp + 512 * j) = hp; }
            }
        };
        auto stageB = [&](const int jt) __attribute__((always_inline)) {
            const LAS unsigned short* hr = (const LAS unsigned short*)(lds + (jt % 3) * SLOTB);
            LAS float* rd = red + (jt & 1) * 4096;
            f32x4 acc0 = (f32x4){0.f, 0.f, 0.f, 0.f}, acc1 = acc0;
            const LAS unsigned short* ap = hr + li * HP + 128 * wave + 8 * lq;
#pragma unroll
            for (int sidx = 0; sidx < 4; ++sidx) { const bf16x8 a = *(const LAS bf16x8*)(ap + 32 * sidx);
                acc0 = __builtin_amdgcn_mfma_f32_16x16x32_bf16(a, wreg[sidx][0], acc0, 0, 0, 0);
                acc1 = __builtin_amdgcn_mfma_f32_16x16x32_bf16(a, wreg[sidx][1], acc1, 0, 0, 0); }
#pragma unroll
            for (int r = 0; r < 4; ++r) { rd[(wave * 16 + 4 * lq + r) * 32 + li] = acc0[r]; rd[(wave * 16 + 4 * lq + r) * 32 + 16 + li] = acc1[r]; }
        };
        auto stageC = [&](const int jt) __attribute__((always_inline)) {
            const LAS float* rd = red + (jt & 1) * 4096;
            const int rt = 2 * wave + (lane >> 5), m = (tl0 + jt) * 16 + rt, lrow = 16 * jt + rt;
            float lg = be;
#pragma unroll
            for (int k = 0; k < 8; ++k) lg += rd[(k * 16 + rt) * 32 + e];
            int sel[4]; float sv[4];
#pragma unroll
            for (int k = 0; k < 4; ++k) {
                float bv = lg;
                bv = __builtin_fmaxf(bv, dppf<DPP_X1>(bv)); bv = __builtin_fmaxf(bv, dppf<DPP_X2>(bv)); bv = __builtin_fmaxf(bv, dppf<DPP_HM>(bv)); bv = __builtin_fmaxf(bv, dppf<DPP_RM>(bv));
                { const auto rv = __builtin_amdgcn_permlane16_swap(__float_as_uint(bv), __float_as_uint(bv), false, false); bv = __builtin_fmaxf(__uint_as_float(rv[0]), __uint_as_float(rv[1])); }
                const unsigned long long bal = __builtin_amdgcn_ballot_w64(lg == bv);
                const int bi = (lane & 32) ? __builtin_ctz((unsigned)(bal >> 32)) : __builtin_ctz((unsigned)bal);
                sel[k] = bi; sv[k] = bv; if (e == bi) lg = -INFINITY;
            }
            if (e == 0 && live) {
                float w[4], ssum = 0.f;
#pragma unroll
                for (int k = 0; k < 4; ++k) { w[k] = __expf(sv[k] - sv[0]); ssum += w[k]; }
                const float rs = 1.f / ssum;
#pragma unroll
                for (int k = 0; k < 4; ++k) { topi[m * 4 + k] = sel[k]; topw[m * 4 + k] = w[k] * rs;
                    if (lrow < 256) { lsel[lrow * 4 + k] = sel[k]; lwt[lrow * 4 + k] = w[k] * rs; lpos[lrow * 4 + k] = __hip_atomic_fetch_add(lcnt + sel[k], 1, __ATOMIC_RELAXED, __HIP_MEMORY_SCOPE_WORKGROUP); }
                    else { const int gp = (int)atomicAdd(ecnt + sel[k], 1u); tpos[m * 4 + k] = gp; list[(size_t)sel[k] * MTOK + gp] = m; lw[(size_t)sel[k] * MTOK + gp] = w[k] * rs; } }
            }
        };
        auto step = [&](const int i) __attribute__((always_inline)) {
            if (i < NT) { const int b = ((tl0 + i) * 16) / SEQ;
                if (b != bcur) { bcur = b;
#pragma unroll
                    for (int j = 0; j < 4; ++j) { const f32x4 gv = *(const f32x4*)(g2 + 4 * lane + 256 * j), sc = *(const f32x4*)(mod + b * NMOD + 4 * DM + 4 * lane + 256 * j);
                        sh2[j] = *(const f32x4*)(mod + b * NMOD + 3 * DM + 4 * lane + 256 * j);
#pragma unroll
                        for (int q = 0; q < 4; ++q) gs2[j][q] = gv[q] * (1.f + sc[q]); } } }
            if (wave < 4) { if (i + 1 < NT) dma(i + 1); if (i < NT) stageA(i); if (i >= 1 && i <= NT) stageB(i - 1); if (i >= 2) stageC(i - 2); }
            else { if (i >= 2) stageC(i - 2); if (i >= 1 && i <= NT) stageB(i - 1); if (i + 1 < NT) dma(i + 1); if (i < NT) stageA(i); }
            __syncthreads();
        };
        for (int i = 0; i < NT + 2; ++i) step(i);
        }
        nloc = 16 * NT;
        __syncthreads();
        if (tid < 32) gbs[tid] = (int)atomicAdd(ecnt + tid, (unsigned)lcnt[tid]);
        __syncthreads();
        { const int nl = nloc < 256 ? nloc : 256;
          for (int sl = tid; sl < nl * 4; sl += NWAVES * 64) { const int lr = sl >> 2, k = sl & 3; const int mm = (tl0 + (lr >> 4)) * 16 + (lr & 15);
              const int ex = lsel[sl], gp = gbs[ex] + lpos[sl]; tpos[mm * 4 + k] = gp; list[(size_t)ex * MTOK + gp] = mm; lw[(size_t)ex * MTOK + gp] = lwt[sl]; } }
        __syncthreads();
    }
    SEAM(6); RELANE();
    LAS int* texp = (LAS int*)(lds + LDS_TEXP);
    if (IN(8) || IN(9) || IN(10)) {
        if (wave == 0) {
            const int ln = lane_id();
            int c = 0, nt = 0;
            if (ln < NEXP) { c = (int)ecnt[ln]; nt = (c + 255) >> 8; texp[700 + ln] = nt; }
            asm volatile("s_waitcnt lgkmcnt(0)" ::: "memory");
            int t = 0;
#pragma unroll
            for (int j = 0; j < NEXP; ++j) { const int v = texp[700 + j]; t += (j < ln) ? v : 0; }
            if (ln < NEXP) { texp[600 + ln] = c; texp[544 + ln] = t; for (int q = 0; q < nt; ++q) texp[t + q] = ln; if (ln == NEXP - 1) texp[544 + NEXP] = t + nt; }
        }
        __syncthreads();
    }
    bf16_t* ACT = (bf16_t*)(ws + F_ACT);
    if (IN(8)) {
        const int T = texp[544 + NEXP];
        pg8::Gemm g{H2, WguT, DM / 2, DM / 2}; pg8::GroupOrder S; S.so.init(T * 256, 2 * DFF, G, bx, REPS(8)); S.texp = texp;
        pg8::EpiSwiglu E{ACT, b_gu, texp};
        pg8::GatherInfo gi{(const int*)(ws + F_LIST), texp + 600, (LAS int*)(lds + LDS_IDX)};
        pg8::gemm_phase<pg8::EpiSwiglu, pg8::GroupOrder, true, true, true, true>(lds, wave, g, S, E, gi);
    }
    SEAM(8); RELANE();
    bf16_t* Y = (bf16_t*)(ws + F_Y);
    if (IN(9)) {
        const int T = texp[544 + NEXP];
        pg8::Gemm g{ACT, WdT, DFF / 2, DFF / 2}; pg8::GroupOrder S; S.so.init(T * 256, DM, G, bx, REPS(9)); S.texp = texp;
        pg8::EpiDown E{Y, b_dn, (const float*)(ws + F_LW), texp};
        pg8::gemm_phase<pg8::EpiDown, pg8::GroupOrder, true, true, false, true>(lds, wave, g, S, E);
    }
    SEAM(9); RELANE();
    for (int rep = 0; rep < (REPS(11) - 1) * 10; ++rep) xcd_barrier(bar);
    if (IN(10)) {
        for (int rep = 0; rep < REPS(10); ++rep) {
        const int rpw = (MTOK + NGW - 1) / NGW, m0 = gw * rpw, m1 = (m0 + rpw < MTOK) ? m0 + rpw : MTOK;
        f32x4 gf[4], gt[4]; int bcur = -1;
#pragma unroll
        for (int j = 0; j < 4; ++j) gf[j] = *(const f32x4*)(g_fin + 4 * lane + 256 * j);
        for (int m = m0; m < m1; m += 2) {
            const bool two = (m + 1 < m1);
            f32x4 v[2][4];
            unsigned yw[2][4][4]; u32x2 mw[2][4];
#pragma unroll
            for (int rr = 0; rr < 2; ++rr) {
                const int mm = (rr && !two) ? m : m + rr;
                const u32x2* mr = (const u32x2*)(MIXG + (size_t)mm * DM) + lane;
                int rows[4];
#pragma unroll
                for (int k = 0; k < 4; ++k) rows[k] = texp[544 + topi[mm * 4 + k]] * 256 + tpos[mm * 4 + k];
#pragma unroll
                for (int j = 0; j < 4; ++j) { mw[rr][j] = mr[64 * j];
#pragma unroll
                    for (int k = 0; k < 4; ++k) yw[rr][j][k] = *(const unsigned*)((const char*)Y + (size_t)rows[k] * DM + 4 * lane + 256 * j); }
            }
#pragma unroll
            for (int rr = 0; rr < 2; ++rr) {
                if (rr == 1 && !two) break;
                const int mm = m + rr, b = mm / SEQ;
                if (b != bcur) { bcur = b;
#pragma unroll
                    for (int j = 0; j < 4; ++j) gt[j] = *(const f32x4*)(mod + b * NMOD + 5 * DM + 4 * lane + 256 * j); }
                float ssum = 0.f;
#pragma unroll
                for (int j = 0; j < 4; ++j) {
                    f32x4 y = (f32x4){0.f, 0.f, 0.f, 0.f};
#pragma unroll
                    for (int k = 0; k < 4; ++k) { const int w = (int)yw[rr][j][k];
                        y[0] += __builtin_amdgcn_cvt_f32_fp8(w, 0); y[1] += __builtin_amdgcn_cvt_f32_fp8(w, 1); y[2] += __builtin_amdgcn_cvt_f32_fp8(w, 2); y[3] += __builtin_amdgcn_cvt_f32_fp8(w, 3); }
                    y = y * (1.f / Y8_SCALE);
                    const u32x2 w = mw[rr][j]; f32x4 mx; mx[0] = __builtin_bit_cast(float, w.x << 16); mx[1] = __builtin_bit_cast(float, w.x & 0xffff0000u); mx[2] = __builtin_bit_cast(float, w.y << 16); mx[3] = __builtin_bit_cast(float, w.y & 0xffff0000u);
                    v[rr][j] = mx + gt[j] * y;
                    ssum += (v[rr][j][0] * v[rr][j][0] + v[rr][j][1] * v[rr][j][1]) + (v[rr][j][2] * v[rr][j][2] + v[rr][j][3] * v[rr][j][3]);
                }
                const float rinv = rsqrtf(wave_sum(ssum) * (1.f / DM) + 1e-6f);
                f32x4* orow = (f32x4*)(args.out + (size_t)mm * DM) + lane;
#pragma unroll
                for (int j = 0; j < 4; ++j) orow[64 * j] = v[rr][j] * rinv * gf[j];
            }
        }
        }
    }
#undef P6_LOAD
#undef IN
#undef SEAM
}

static int mk_grid = 0;
static void launch_mk(void* const* d_in, void* d_out, void* d_ws, int lo, int hi, int li, hipStream_t stream) {
    if (mk_grid == 0) {
        int dev = 0, cus = 0;
        if (hipGetDevice(&dev) != hipSuccess || hipDeviceGetAttribute(&cus, hipDeviceAttributeMultiprocessorCount, dev) != hipSuccess) { mk_grid = -1; return; }
        if (hipFuncSetAttribute((const void*)mk_fwd, hipFuncAttributeMaxDynamicSharedMemorySize, LDS_BYTES) != hipSuccess) { fprintf(stderr, "hipFuncSetAttribute failed\n"); mk_grid = -1; return; }
        mk_grid = cus;
    }
    if (mk_grid < 0) return;
    MkArgs a{};
    for (int i = 0; i < 25; ++i) a.in[i] = (const float*)d_in[i];
    a.out = (float*)d_out; a.ws = (unsigned char*)d_ws; a.ph_lo_hi = (long long)lo | ((long long)hi << 16) | ((long long)li << 32);
    hipLaunchKernelGGL(mk_fwd, dim3(mk_grid), dim3(NWAVES * 64), LDS_BYTES, stream, a);
}
extern "C" void kernel_launch(void* const* d_in, const int* in_sizes, int n_in, void* d_out, int out_size, void* d_ws, size_t ws_size, hipStream_t stream) {
    if (n_in != 25 || out_size != MTOK * DM || ws_size < F_END) { fprintf(stderr, "kernel_launch: built for 25 inputs, %d outputs, >= %zu bytes of workspace; got n_in %d, out %d, ws %zu; nothing launched\n", MTOK * DM, (size_t)F_END, n_in, out_size, ws_size); return; }
    (void)in_sizes;
    (void)hipMemsetAsync((char*)d_ws + F_CTL, 0, 64 * 1024, stream);
    launch_mk(d_in, d_out, d_ws, 0, N_PHASES, 0, stream);
}
```
